# Optimizing an MI355X kernel written in HIP

```python
import jax, jax.numpy as jnp
from jax import lax
import numpy as np

D_MODEL = 1024
BATCH = 8
SEQ = 8192
DEPTH = 1
DEC_BATCH = 16
DEC_SEQ = 16
PAST_LEN = 1024

CHUNK = 64
MIX_WIDTH = D_MODEL
HEAD_DIM = 64
RWKV_WIDTH = MIX_WIDTH // 2
RWKV_HEADS = RWKV_WIDTH // HEAD_DIM
ATT_WIDTH = MIX_WIDTH - RWKV_WIDTH
ATT_HEADS = ATT_WIDTH // HEAD_DIM
DECAY_LORA = 64
ICLR_LORA = 64
GATE_LORA = 128
RWKV_COLS = 3 * RWKV_WIDTH + DECAY_LORA + ICLR_LORA + GATE_LORA
RWKV_SPLITS = [RWKV_WIDTH, 2 * RWKV_WIDTH, 3 * RWKV_WIDTH,
               3 * RWKV_WIDTH + DECAY_LORA, 3 * RWKV_WIDTH + DECAY_LORA + ICLR_LORA]
ATT_COLS = 3 * ATT_WIDTH
IN_COLS = RWKV_COLS + ATT_COLS
LEFT_CHUNKS = 8
ATT_WINDOW = LEFT_CHUNKS * CHUNK
BAND = ATT_WINDOW + CHUNK
REL_MAX = 128
N_REL = 2 * REL_MAX + 1
D_FF = 2816
NORM_EPS = 1e-5
GN_EPS = 64e-5
NEG_INF = -1e30

kernel_name = "rwkv7_chunkband_hymba_macaron_step"


def _rms_norm(x, g):
    xf = x.astype(jnp.float32)
    xf = xf * lax.rsqrt(jnp.mean(xf * xf, axis=-1, keepdims=True) + NORM_EPS)
    return (xf * g.astype(jnp.float32)).astype(x.dtype)


def _swiglu(x, w_gate, w_up, w_down):
    return (jax.nn.silu(x @ w_gate) * (x @ w_up)) @ w_down


def _wkv_scan(r, decay, k, v, kk, a, s0):
    def step(s, inp):
        r_t, w_t, k_t, v_t, kk_t, a_t = inp
        sa = jnp.einsum('bhvk,bhk->bhv', s, kk_t)
        s = (s * w_t[:, :, None, :] - sa[..., None] * (kk_t * a_t)[:, :, None, :]
             + v_t[..., None] * k_t[:, :, None, :])
        y_t = jnp.einsum('bhvk,bhk->bhv', s, r_t)
        return s, y_t
    xs = (jnp.moveaxis(r, 1, 0), jnp.moveaxis(decay, 1, 0), jnp.moveaxis(k, 1, 0),
          jnp.moveaxis(v, 1, 0), jnp.moveaxis(kk, 1, 0), jnp.moveaxis(a, 1, 0))
    s, ys = lax.scan(step, s0, xs)
    return jnp.moveaxis(ys, 0, 1), s


def _rwkv7(p, shift_prev, wkv_prev, mu_shift, w0, w_lora_up, a0, a_lora_up, g_lora_up,
           k_k, k_a, r_k, ln_x_w, ln_x_b):
    B, T, _ = p.shape
    f32 = jnp.float32
    prev = jnp.concatenate([shift_prev[:, None, :].astype(p.dtype), p[:, :-1]], axis=1)
    xs = p + (prev - p) * mu_shift
    r, k, v, wd, ad, gd = jnp.split(xs, RWKV_SPLITS, axis=-1)
    log_w = -jax.nn.softplus(-(w0 + jnp.tanh(wd) @ w_lora_up).astype(f32)) - 0.5
    decay = jnp.exp(-jnp.exp(log_w))
    a = jax.nn.sigmoid((a0 + ad @ a_lora_up).astype(f32))
    g = (jax.nn.sigmoid(gd) @ g_lora_up).astype(f32)
    hs = (B, T, RWKV_HEADS, HEAD_DIM)
    r4 = r.astype(f32).reshape(hs)
    v4 = v.astype(f32).reshape(hs)
    w4 = decay.reshape(hs)
    a4 = a.reshape(hs)
    kk = (k * k_k).astype(f32).reshape(hs)
    kk = kk * lax.rsqrt(jnp.maximum(jnp.sum(kk * kk, axis=-1, keepdims=True), 1e-24))
    k4 = k.astype(f32).reshape(hs) * (1.0 + (a4 - 1.0) * k_a.astype(f32).reshape(RWKV_HEADS, HEAD_DIM))
    y, s = _wkv_scan(r4, w4, k4, v4, kk, a4, wkv_prev.astype(f32))
    mean = jnp.mean(y, axis=-1, keepdims=True)
    var = jnp.mean(jnp.square(y - mean), axis=-1, keepdims=True)
    yn = ((y - mean) * lax.rsqrt(var + GN_EPS)).reshape(B, T, RWKV_WIDTH)
    yn = yn * ln_x_w.astype(f32) + ln_x_b.astype(f32)
    bonus = (jnp.sum(r4 * k4 * r_k.astype(f32), axis=-1, keepdims=True) * v4).reshape(B, T, RWKV_WIDTH)
    out = (yn + bonus) * g
    return out.astype(p.dtype), s


def _rel_bias(table, rel):
    idx = jnp.clip(rel, -REL_MAX, REL_MAX) + REL_MAX
    return table[:, idx].astype(jnp.float32)


def _attend(q, k, v, bias, valid):
    s = jnp.einsum('bhqd,bhkd->bhqk', q.astype(jnp.float32), k.astype(jnp.float32)) * (HEAD_DIM ** -0.5)
    s = s + bias[None]
    if valid is not None:
        s = jnp.where(valid, s, NEG_INF)
    p = jax.nn.softmax(s, axis=-1)
    return jnp.einsum('bhqk,bhkd->bhqd', p, v.astype(jnp.float32)).astype(q.dtype)


def _band_attention_prompt(q, k, v, rel_bias):
    B, H, T, Dh = q.shape
    n_chunks = T // CHUNK
    pad = ((0, 0), (0, 0), (ATT_WINDOW, 0), (0, 0))
    kp = jnp.pad(k, pad)
    vp = jnp.pad(v, pad)
    qi = jnp.arange(CHUNK)
    kj = jnp.arange(BAND)
    bias = _rel_bias(rel_bias, kj[None, :] - ATT_WINDOW - qi[:, None])

    def one_chunk(c):
        start = c * CHUNK
        qc = lax.dynamic_slice_in_dim(q, start, CHUNK, axis=2)
        kc = lax.dynamic_slice_in_dim(kp, start, BAND, axis=2)
        vc = lax.dynamic_slice_in_dim(vp, start, BAND, axis=2)
        valid = (start - ATT_WINDOW + kj)[None, :] >= 0
        return _attend(qc, kc, vc, bias, valid)

    o = lax.map(one_chunk, jnp.arange(n_chunks))
    return o.transpose(1, 0, 3, 2, 4).reshape(B, T, H * Dh)


def _band_attention_step(q, k, v, k_cache, v_cache, rel_bias):
    B, H, T, Dh = q.shape
    L = k_cache.shape[2]
    kf = jnp.concatenate([k_cache.astype(k.dtype), k], axis=2)
    vf = jnp.concatenate([v_cache.astype(v.dtype), v], axis=2)
    rel = (jnp.arange(L + T) - L)[None, :] - jnp.arange(T)[:, None]
    o = _attend(q, kf, vf, _rel_bias(rel_bias, rel), None)
    return o.transpose(0, 2, 1, 3).reshape(B, T, H * Dh)


def _layer(x, shift_prev, wkv_prev, k_cache, v_cache, w):
    (norm_ff1, w_ff1_gate, w_ff1_up, w_ff1_down, norm_mix, w_in, mu_shift, w0, w_lora_up,
     a0, a_lora_up, g_lora_up, k_k, k_a, r_k, ln_x_w, ln_x_b, rel_bias, w_out,
     norm_ff2, w_ff2_gate, w_ff2_up, w_ff2_down) = w
    B, T, _ = x.shape
    x = x + 0.5 * _swiglu(_rms_norm(x, norm_ff1), w_ff1_gate, w_ff1_up, w_ff1_down)
    h = _rms_norm(x, norm_mix)
    proj = h @ w_in
    p_rwkv = proj[..., :RWKV_COLS]
    p_att = proj[..., RWKV_COLS:]
    if shift_prev is None:
        shift_prev = jnp.zeros((B, RWKV_COLS), x.dtype)
        wkv_prev = jnp.zeros((B, RWKV_HEADS, HEAD_DIM, HEAD_DIM), jnp.float32)
    rwkv_out, wkv_new = _rwkv7(p_rwkv, shift_prev, wkv_prev, mu_shift, w0, w_lora_up, a0,
                               a_lora_up, g_lora_up, k_k, k_a, r_k, ln_x_w, ln_x_b)
    q, k, v = jnp.split(p_att, 3, axis=-1)
    q = q.reshape(B, T, ATT_HEADS, HEAD_DIM).transpose(0, 2, 1, 3)
    k = k.reshape(B, T, ATT_HEADS, HEAD_DIM).transpose(0, 2, 1, 3)
    v = v.reshape(B, T, ATT_HEADS, HEAD_DIM).transpose(0, 2, 1, 3)
    if k_cache is None:
        att = _band_attention_prompt(q, k, v, rel_bias)
        n_keep = min(ATT_WINDOW, T)
        k_rows, v_rows = k[:, :, T - n_keep:], v[:, :, T - n_keep:]
    else:
        att = _band_attention_step(q, k, v, k_cache, v_cache, rel_bias)
        k_rows, v_rows = k, v
    x = x + jnp.concatenate([rwkv_out, att], axis=-1) @ w_out
    x = x + 0.5 * _swiglu(_rms_norm(x, norm_ff2), w_ff2_gate, w_ff2_up, w_ff2_down)
    return x, p_rwkv[:, -1], wkv_new.astype(x.dtype), k_rows, v_rows


def setup_inputs(seed: int = 0) -> dict:
    key = jax.random.key(seed)
    ks = jax.random.split(key, 32)
    f32 = jnp.float32

    def nrm(k, shape, s):
        return jax.random.normal(k, shape, f32) * s

    L_cache = min(ATT_WINDOW, PAST_LEN)
    Dp = (DEPTH,)
    return {
        "x_prompt": nrm(ks[0], (BATCH, SEQ, D_MODEL), 1.0),
        "x_sample": nrm(ks[1], (DEC_BATCH, DEC_SEQ, D_MODEL), 1.0),
        "state_shift": nrm(ks[2], Dp + (DEC_BATCH, RWKV_COLS), 1.0),
        "state_wkv": nrm(ks[3], Dp + (DEC_BATCH, RWKV_HEADS, HEAD_DIM, HEAD_DIM), 0.3),
        "cache_attn_k": nrm(ks[4], Dp + (DEC_BATCH, ATT_HEADS, L_cache, HEAD_DIM), 1.0),
        "cache_attn_v": nrm(ks[5], Dp + (DEC_BATCH, ATT_HEADS, L_cache, HEAD_DIM), 1.0),
        "norm_ff1": 1.0 + nrm(ks[6], Dp + (D_MODEL,), 0.01),
        "w_ff1_gate": nrm(ks[7], Dp + (D_MODEL, D_FF), D_MODEL ** -0.5),
        "w_ff1_up": nrm(ks[8], Dp + (D_MODEL, D_FF), D_MODEL ** -0.5),
        "w_ff1_down": nrm(ks[9], Dp + (D_FF, D_MODEL), D_FF ** -0.5),
        "norm_mix": 1.0 + nrm(ks[10], Dp + (D_MODEL,), 0.01),
        "w_in": nrm(ks[11], Dp + (D_MODEL, IN_COLS), D_MODEL ** -0.5),
        "mu_shift": jax.random.uniform(ks[12], Dp + (RWKV_COLS,), f32),
        "w0": nrm(ks[13], Dp + (RWKV_WIDTH,), 0.5) - 0.5,
        "w_lora_up": nrm(ks[14], Dp + (DECAY_LORA, RWKV_WIDTH), 0.5 * DECAY_LORA ** -0.5),
        "a0": nrm(ks[15], Dp + (RWKV_WIDTH,), 0.1),
        "a_lora_up": nrm(ks[16], Dp + (ICLR_LORA, RWKV_WIDTH), 0.5 * ICLR_LORA ** -0.5),
        "g_lora_up": nrm(ks[17], Dp + (GATE_LORA, RWKV_WIDTH), GATE_LORA ** -0.5),
        "k_k": 0.85 + nrm(ks[18], Dp + (RWKV_WIDTH,), 0.02),
        "k_a": 1.0 + nrm(ks[19], Dp + (RWKV_WIDTH,), 0.02),
        "r_k": nrm(ks[20], Dp + (RWKV_HEADS, HEAD_DIM), 0.1),
        "ln_x_w": 1.0 + nrm(ks[21], Dp + (RWKV_WIDTH,), 0.01),
        "ln_x_b": nrm(ks[22], Dp + (RWKV_WIDTH,), 0.01),
        "rel_bias": nrm(ks[23], Dp + (ATT_HEADS, N_REL), 0.1),
        "w_out": nrm(ks[24], Dp + (MIX_WIDTH, D_MODEL), MIX_WIDTH ** -0.5),
        "norm_ff2": 1.0 + nrm(ks[25], Dp + (D_MODEL,), 0.01),
        "w_ff2_gate": nrm(ks[26], Dp + (D_MODEL, D_FF), D_MODEL ** -0.5),
        "w_ff2_up": nrm(ks[27], Dp + (D_MODEL, D_FF), D_MODEL ** -0.5),
        "w_ff2_down": nrm(ks[28], Dp + (D_FF, D_MODEL), D_FF ** -0.5),
        "norm_final": 1.0 + nrm(ks[29], (D_MODEL,), 0.01),
    }


def reference(x_prompt, x_sample, state_shift, state_wkv, cache_attn_k, cache_attn_v,
              norm_ff1, w_ff1_gate, w_ff1_up, w_ff1_down, norm_mix, w_in, mu_shift, w0,
              w_lora_up, a0, a_lora_up, g_lora_up, k_k, k_a, r_k, ln_x_w, ln_x_b,
              rel_bias, w_out, norm_ff2, w_ff2_gate, w_ff2_up, w_ff2_down, norm_final):
    xp = x_prompt
    xs = x_sample
    p_shift, p_wkv, p_k, p_v = [], [], [], []
    s_shift, s_wkv, s_k, s_v = [], [], [], []
    for l in range(DEPTH):
        w = (norm_ff1[l], w_ff1_gate[l], w_ff1_up[l], w_ff1_down[l], norm_mix[l], w_in[l],
             mu_shift[l], w0[l], w_lora_up[l], a0[l], a_lora_up[l], g_lora_up[l], k_k[l],
             k_a[l], r_k[l], ln_x_w[l], ln_x_b[l], rel_bias[l], w_out[l], norm_ff2[l],
             w_ff2_gate[l], w_ff2_up[l], w_ff2_down[l])
        xp, sh, wk, kr, vr = _layer(xp, None, None, None, None, w)
        p_shift.append(sh); p_wkv.append(wk); p_k.append(kr); p_v.append(vr)
        xs, sh, wk, kr, vr = _layer(xs, state_shift[l], state_wkv[l], cache_attn_k[l],
                                    cache_attn_v[l], w)
        s_shift.append(sh); s_wkv.append(wk); s_k.append(kr); s_v.append(vr)
    y_prompt = _rms_norm(xp, norm_final)
    y_sample = _rms_norm(xs, norm_final)
    return (y_prompt, y_sample,
            jnp.stack(p_shift), jnp.stack(p_wkv), jnp.stack(p_k), jnp.stack(p_v),
            jnp.stack(s_shift), jnp.stack(s_wkv), jnp.stack(s_k), jnp.stack(s_v))
```

```cpp
#include <hip/hip_runtime.h>


#include <hip/hip_cooperative_groups.h>
#include <cstdio>
namespace cg = cooperative_groups;

#define LAS __attribute__((address_space(3)))
typedef unsigned short bf16_t;
typedef short bf16x8 __attribute__((ext_vector_type(8)));
typedef float f32x4 __attribute__((ext_vector_type(4)));
typedef float f32x2 __attribute__((ext_vector_type(2)));
typedef unsigned u32x4 __attribute__((ext_vector_type(4)));
typedef unsigned u32x2 __attribute__((ext_vector_type(2)));

constexpr int MP = 65536, MS = 256, M = MP + MS, D = 1024, FF = 2816, NIN = 3328, RC = 1792, AC = 1536, RW = 512;
constexpr int SEQ = 8192;
constexpr float NORM_EPS = 1e-5f, GN_EPS = 64e-5f;
constexpr size_t O_YP = 0, O_YS = 67108864, O_PSH = 67371008, O_PWKV = 67385344, O_PK = 67647488, O_PV = 69744640,
                 O_SSH = 71841792, O_SWKV = 71870464, O_SK = 72394752, O_SV = 72525824;
constexpr size_t SSB = (size_t)M * 4;
constexpr size_t WS_SS1 = 65536, WS_SS2 = WS_SS1 + SSB, WS_SS3 = WS_SS2 + SSB, WS_SS4 = WS_SS3 + SSB;
constexpr size_t WS_BON = 2097152;
constexpr size_t WS_W = 5242880;
constexpr size_t WS_WGU1 = WS_W, WS_WD1 = WS_WGU1 + (size_t)2 * FF * D * 2, WS_WIN = WS_WD1 + (size_t)D * FF * 2, WS_WOUT = WS_WIN + (size_t)NIN * D * 2,
                 WS_WGU2 = WS_WOUT + (size_t)D * D * 2, WS_WD2 = WS_WGU2 + (size_t)2 * FF * D * 2, WS_WL = WS_WD2 + (size_t)D * FF * 2,
                 WS_AL = WS_WL + 512 * 64 * 2, WS_GL = WS_AL + 512 * 64 * 2, WS_WEND = WS_GL + 512 * 128 * 2;
constexpr size_t WS_XB = WS_WEND;
constexpr size_t WS_PR = WS_XB + (size_t)M * D * 2;
constexpr size_t WS_PA = WS_PR + (size_t)M * RC * 2;
constexpr size_t WS_S5 = WS_PA + (size_t)M * AC * 2;
constexpr size_t S5B = (size_t)M * RW * 2;
constexpr size_t WS_G = WS_S5 + 5 * S5B;
constexpr size_t WS_INV = WS_G + S5B;
constexpr size_t WS_SLAB = WS_INV + (size_t)M * 8 * 4;
constexpr size_t WS_END = WS_SLAB + (size_t)11 * MS * D * 4;
constexpr int LDS_BYTES = 131072 + 2048;

typedef __bf16 bf16x2_t __attribute__((ext_vector_type(2)));
__device__ __forceinline__ unsigned cvt_pk_bf16(float lo, float hi) { const f32x2 v = {lo, hi}; return __builtin_bit_cast(unsigned, __builtin_convertvector(v, bf16x2_t)); }
__device__ __forceinline__ float bf2f(unsigned short u) { return __builtin_bit_cast(float, (unsigned)u << 16); }
__device__ __forceinline__ float bflo(unsigned u) { return __builtin_bit_cast(float, u << 16); }
__device__ __forceinline__ float bfhi(unsigned u) { return __builtin_bit_cast(float, u & 0xffff0000u); }
__device__ __forceinline__ unsigned short f2bf(float f) { return __builtin_bit_cast(unsigned short, (__bf16)f); }
__device__ __forceinline__ float wave_sum(float v) {
#pragma unroll
    for (int o = 1; o < 64; o <<= 1) v += __shfl_xor(v, o);
    return v;
}
__device__ __forceinline__ float wave_max(float v) {
#pragma unroll
    for (int o = 1; o < 64; o <<= 1) v = fmaxf(v, __shfl_xor(v, o));
    return v;
}
template <int CTRL> __device__ __forceinline__ float dppf(float v) { return __builtin_bit_cast(float, __builtin_amdgcn_mov_dpp(__builtin_bit_cast(int, v), CTRL, 0xF, 0xF, true)); }
__device__ __forceinline__ float row16_sum(float v) { v += dppf<0xB1>(v); v += dppf<0x4E>(v); v += dppf<0x141>(v); v += dppf<0x140>(v); return v; }
__device__ __forceinline__ float row8_sum(float v) { v += dppf<0xB1>(v); v += dppf<0x4E>(v); v += dppf<0x141>(v); return v; }
__device__ __forceinline__ float fast_exp(float x) { return __builtin_amdgcn_exp2f(x * 1.44269504089f); }
__device__ __forceinline__ float sigmoidf_(float x) { return __builtin_amdgcn_rcpf(1.f + fast_exp(-x)); }

__device__ __forceinline__ float xsum_quads(float v) {
    unsigned u = __builtin_bit_cast(unsigned, v);
    auto r = __builtin_amdgcn_permlane16_swap(u, u, false, false);
    v = __builtin_bit_cast(float, (unsigned)r[0]) + __builtin_bit_cast(float, (unsigned)r[1]);
    u = __builtin_bit_cast(unsigned, v);
    auto q = __builtin_amdgcn_permlane32_swap(u, u, false, false);
    return __builtin_bit_cast(float, (unsigned)q[0]) + __builtin_bit_cast(float, (unsigned)q[1]);
}

__device__ __forceinline__ float xmax_quads(float v) {
    unsigned u = __builtin_bit_cast(unsigned, v);
    auto r = __builtin_amdgcn_permlane16_swap(u, u, false, false);
    v = fmaxf(__builtin_bit_cast(float, (unsigned)r[0]), __builtin_bit_cast(float, (unsigned)r[1]));
    u = __builtin_bit_cast(unsigned, v);
    auto q = __builtin_amdgcn_permlane32_swap(u, u, false, false);
    return fmaxf(__builtin_bit_cast(float, (unsigned)q[0]), __builtin_bit_cast(float, (unsigned)q[1]));
}

namespace pg8 {
constexpr int BM = 256, BK = 64, HALF = 128, HTB = HALF * BK * 2, STAGE_BYTES = 8 * HTB, NXCD = 8, WGM = 8;
__host__ __device__ __forceinline__ int lds_byte(int r, int c) { const int st = (r >> 4) * 2 + (c >> 5), rr = r & 15, cc = c & 31, ob = rr * 64 + cc * 2; return st * 1024 + (ob ^ (((ob >> 9) & 1) << 5)); }
__host__ __device__ __forceinline__ void stage_rc(int b, int& R, int& C) { const int st = b / 1024, sb = b % 1024, swz = sb ^ (((sb >> 9) & 1) << 5); R = (st >> 1) * 16 + swz / 64; C = (st & 1) * 32 + (swz % 64) / 2; }
__host__ __device__ __forceinline__ int perm32(int rho) { const int n = rho >> 4, i = rho & 15; return 8 * (i >> 2) + 4 * n + (i & 3); }
struct Unit { int pm, pk;
    __device__ __forceinline__ int pn() const { return pk & 0xff; } __device__ __forceinline__ int kt0() const { return (pk >> 8) & 0xff; }
    __device__ __forceinline__ int nt() const { return (pk >> 16) & 0xff; } __device__ __forceinline__ int slice() const { return pk >> 24; } };
struct Gemm { const bf16_t* A; const bf16_t* Bt; int M, N, K; };
struct StaticOrder {
    int nM, nN, nwg, G, c, ntf, nsl, nts;
    __device__ __forceinline__ void init(int M_, int N_, int K_, int G_, int c_, int nsl_) { nM = M_ / BM; nN = N_ / BM; nwg = nM * nN; G = G_; c = c_; ntf = K_ / BK; nsl = nsl_; nts = nsl_ ? ntf / nsl_ : 0; }
    __device__ __forceinline__ bool next(int i, Unit& u) const {
        const long L = (long)i * G + c;
        if (L >= nwg) {
            const long sidx = L - nwg; if (sidx >= (long)nN * nsl) return false;
            u.pm = nM; u.pk = (int)(sidx % nN) | (((int)(sidx / nN) * nts) << 8) | (nts << 16) | (1 << 24); return true;
        }
        int wgid = (int)L; { const int q = nwg / NXCD, r = nwg % NXCD, xcd = wgid % NXCD, off = wgid / NXCD; wgid = (xcd < r ? xcd * (q + 1) : r * (q + 1) + (xcd - r) * q) + off; }
        const int nig = WGM * nN, gid = wgid / nig, fm = gid * WGM, gsz = (nM - fm) < WGM ? (nM - fm) : WGM;
        u.pm = fm + ((wgid % nig) % gsz); u.pk = ((wgid % nig) / gsz) | (ntf << 16); return true;
    }
};

template <class Epi, bool SLICED = false>
__device__ __forceinline__ void gemm_phase(LAS unsigned char* lds, const Gemm g, const StaticOrder& S, const Epi& E) {
    const int tid = threadIdx.x, wid = __builtin_amdgcn_readfirstlane(tid >> 6), lane = tid & 63, wr = wid >> 2, wc = wid & 3, fr = lane & 15, fq = lane >> 4;
    const int K = g.K;
    unsigned voffA[2], voffB[2];
#pragma unroll
    for (int i = 0; i < 2; ++i) { int R, C; stage_rc(tid * 16 + i * 8192, R, C); const int Rb = Epi::PERM ? ((R & ~31) + perm32(R & 31)) : R;
        voffA[i] = (unsigned)(R * K + C) * 2u; voffB[i] = (unsigned)(Rb * K + C) * 2u; }
    const size_t kstep = (size_t)(BK * 2);
    const size_t hstep = (size_t)HALF * K * 2;
    const size_t tstep = 2 * hstep;
    const unsigned ldsw = (unsigned)wid * 1024u;
    const int aoff = lds_byte(wr * 64 + fr, fq * 8), boff = lds_byte(wc * 32 + fr, fq * 8);
#define PG8_SA(b, h) (((b) * 2 + (h)) * HTB)
#define PG8_SB(b, h) ((4 + (b) * 2 + (h)) * HTB)
#define PG8_STAGE(bufoff, gbase, voff) do { _Pragma("unroll") for (int _i = 0; _i < 2; ++_i) \
        __builtin_amdgcn_global_load_lds((const unsigned*)((const char*)(gbase) + (voff)[_i]), (LAS unsigned*)(lds + (bufoff) + ldsw + _i * 8192), 16, 0, 0); } while (0)
#define PG8_LDA(dst, b, h) do { _Pragma("unroll") for (int m = 0; m < 4; ++m) _Pragma("unroll") for (int k = 0; k < 2; ++k) dst[m][k] = *(const LAS bf16x8*)(lds + PG8_SA(b, h) + aoff + m * 2048 + k * 1024); } while (0)
#define PG8_LDB(dst, b, h) do { _Pragma("unroll") for (int n = 0; n < 2; ++n) _Pragma("unroll") for (int k = 0; k < 2; ++k) dst[n][k] = *(const LAS bf16x8*)(lds + PG8_SB(b, h) + boff + n * 2048 + k * 1024); } while (0)
#define PG8_MMA(ai, bj, At, Bt) do { __builtin_amdgcn_s_setprio(1); _Pragma("unroll") for (int m = 0; m < 4; ++m) _Pragma("unroll") for (int n = 0; n < 2; ++n) _Pragma("unroll") for (int k = 0; k < 2; ++k) \
        acc[ai][bj][m][n] = __builtin_amdgcn_mfma_f32_16x16x32_bf16(Bt[n][k], At[m][k], acc[ai][bj][m][n], 0, 0, 0); __builtin_amdgcn_s_setprio(0); } while (0)
#define PG8_WAIT_V(n) asm volatile("s_waitcnt vmcnt(" #n ")" ::: "memory")
#define PG8_WAIT_L(n) asm volatile("s_waitcnt lgkmcnt(" #n ")" ::: "memory")
#define PG8_BAR __builtin_amdgcn_s_barrier()
#define PG8_SCHED __builtin_amdgcn_sched_barrier(0)
    Unit cur, nxt; int ui = 0;
    if (!S.next(0, cur)) return;
    f32x4 acc[2][2][4][2];
#pragma unroll
    for (int a = 0; a < 2; ++a)
#pragma unroll
        for (int b = 0; b < 2; ++b)
#pragma unroll
            for (int m = 0; m < 4; ++m)
#pragma unroll
                for (int n = 0; n < 2; ++n) acc[a][b][m][n] = (f32x4){0.f, 0.f, 0.f, 0.f};
    bf16x8 At[4][2], B0[2][2], B1[2][2];
    const char* cA = (const char*)g.A + (size_t)cur.pm * tstep + (SLICED ? (size_t)cur.kt0() * kstep : 0); const char* cB = (const char*)g.Bt + (size_t)cur.pn() * tstep + (SLICED ? (size_t)cur.kt0() * kstep : 0);
    PG8_STAGE(PG8_SB(0, 0), cB, voffB); PG8_STAGE(PG8_SA(0, 0), cA, voffA); PG8_STAGE(PG8_SB(0, 1), cB + hstep, voffB); PG8_STAGE(PG8_SA(0, 1), cA + hstep, voffA);
    if (wr == 1) PG8_BAR;
    PG8_WAIT_V(4); PG8_BAR;
    PG8_STAGE(PG8_SB(1, 0), cB + kstep, voffB); PG8_STAGE(PG8_SA(1, 0), cA + kstep, voffA); PG8_STAGE(PG8_SB(1, 1), cB + hstep + kstep, voffB);
    PG8_WAIT_V(6); PG8_BAR;
    for (;;) {
        const bool has_next = S.next(ui + 1, nxt);
        const char* nA = has_next ? (const char*)g.A + (size_t)nxt.pm * tstep + (SLICED ? (size_t)nxt.kt0() * kstep : 0) : cA; const char* nB = has_next ? (const char*)g.Bt + (size_t)nxt.pn() * tstep + (SLICED ? (size_t)nxt.kt0() * kstep : 0) : cB;
        const int nt = SLICED ? cur.nt() : K / BK;
        for (int t = 0; t < nt; t += 2) {
            const bool last = (t == nt - 2);
            const char* a1 = cA + (size_t)(t + 1) * kstep;
            const char* a2 = last ? nA : cA + (size_t)(t + 2) * kstep; const char* b2 = last ? nB : cB + (size_t)(t + 2) * kstep;
            const char* a3 = a2 + kstep; const char* b3 = b2 + kstep;
            PG8_LDB(B0, 0, 0); PG8_SCHED; PG8_LDA(At, 0, 0); PG8_STAGE(PG8_SA(1, 1), a1 + hstep, voffA);
            PG8_WAIT_L(8); PG8_BAR; PG8_WAIT_L(0); PG8_MMA(0, 0, At, B0); PG8_BAR; PG8_SCHED;
            PG8_LDB(B1, 0, 1); PG8_STAGE(PG8_SB(0, 0), b2, voffB);
            PG8_BAR; PG8_WAIT_L(0); PG8_MMA(0, 1, At, B1); PG8_BAR;
            PG8_LDA(At, 0, 1); PG8_STAGE(PG8_SA(0, 0), a2, voffA);
            PG8_BAR; PG8_WAIT_L(0); PG8_MMA(1, 0, At, B0); PG8_BAR; PG8_SCHED;
            PG8_STAGE(PG8_SB(0, 1), b2 + hstep, voffB);
            PG8_WAIT_V(6); PG8_BAR; PG8_MMA(1, 1, At, B1); PG8_BAR;
            PG8_LDB(B0, 1, 0); PG8_SCHED; PG8_LDA(At, 1, 0); PG8_STAGE(PG8_SA(0, 1), a2 + hstep, voffA);
            PG8_WAIT_L(8); PG8_BAR; PG8_WAIT_L(0); PG8_MMA(0, 0, At, B0); PG8_BAR; PG8_SCHED;
            PG8_LDB(B1, 1, 1); PG8_STAGE(PG8_SB(1, 0), b3, voffB);
            PG8_BAR; PG8_WAIT_L(0); PG8_MMA(0, 1, At, B1); PG8_BAR;
            PG8_LDA(At, 1, 1); PG8_STAGE(PG8_SA(1, 0), a3, voffA);
            PG8_BAR; PG8_WAIT_L(0); PG8_MMA(1, 0, At, B0); PG8_BAR; PG8_SCHED;
            PG8_STAGE(PG8_SB(1, 1), b3 + hstep, voffB);
            PG8_WAIT_V(6); PG8_BAR; PG8_MMA(1, 1, At, B1); PG8_BAR;
        }
        E(acc, cur, wr, wc, fr, fq);
        if (!has_next) break;
#pragma unroll
        for (int a = 0; a < 2; ++a)
#pragma unroll
            for (int b = 0; b < 2; ++b)
#pragma unroll
                for (int m = 0; m < 4; ++m)
#pragma unroll
                    for (int n = 0; n < 2; ++n) acc[a][b][m][n] = (f32x4){0.f, 0.f, 0.f, 0.f};
        cur = nxt; cA = nA; cB = nB; ++ui;
    }
    PG8_WAIT_V(0);
    if (wr == 0) PG8_BAR;
    PG8_BAR;
#undef PG8_SA
#undef PG8_SB
#undef PG8_STAGE
#undef PG8_LDA
#undef PG8_LDB
#undef PG8_MMA
#undef PG8_WAIT_V
#undef PG8_WAIT_L
#undef PG8_BAR
#undef PG8_SCHED
}
}

struct EpiGU {
    static constexpr bool PERM = true;
    bf16_t* O; const float* ss;
    __device__ __forceinline__ void operator()(const f32x4 (&acc)[2][2][4][2], const pg8::Unit& u, int wr, int wc, int fr, int fq) const {
        const int row0 = u.pm * 256 + wr * 64 + fr, col0 = u.pn() * 128 + wc * 32 + 8 * fq;
#pragma unroll
        for (int ai = 0; ai < 2; ++ai)
#pragma unroll
            for (int m = 0; m < 4; ++m) {
                const int row = row0 + ai * 128 + m * 16;
                const float rs = rsqrtf(ss[row] * (1.f / 1024.f) + NORM_EPS);
                f32x4 ov[2];
#pragma unroll
                for (int n = 0; n < 2; ++n) {
                    const f32x4 g4 = acc[ai][0][m][n] * rs, u4 = acc[ai][1][m][n] * rs;
                    const f32x4 t4 = g4 * (-1.44269504089f);
                    f32x4 e4; e4.x = __builtin_amdgcn_exp2f(t4.x); e4.y = __builtin_amdgcn_exp2f(t4.y); e4.z = __builtin_amdgcn_exp2f(t4.z); e4.w = __builtin_amdgcn_exp2f(t4.w);
                    const f32x4 d4 = e4 + 1.0f;
                    f32x4 r4; r4.x = __builtin_amdgcn_rcpf(d4.x); r4.y = __builtin_amdgcn_rcpf(d4.y); r4.z = __builtin_amdgcn_rcpf(d4.z); r4.w = __builtin_amdgcn_rcpf(d4.w);
                    ov[n] = (g4 * u4) * r4;
                }
                u32x4 w; w.x = cvt_pk_bf16(ov[0].x, ov[0].y); w.y = cvt_pk_bf16(ov[0].z, ov[0].w); w.z = cvt_pk_bf16(ov[1].x, ov[1].y); w.w = cvt_pk_bf16(ov[1].z, ov[1].w);
                *(u32x4*)(O + (size_t)row * FF + col0) = w;
            }
    }
};
struct EpiRes {
    static constexpr bool PERM = true;
    const float* resP; const float* resS; float* XR; bf16_t* XBo; float* ssn; float scale; float* slab; int nts;
    __device__ __forceinline__ void operator()(const f32x4 (&acc)[2][2][4][2], const pg8::Unit& u, int wr, int wc, int fr, int fq) const {
        const int row0 = u.pm * 256 + wr * 64 + fr, col0 = u.pn() * 256 + wc * 32 + 8 * fq;
        if (u.slice()) {
            float* sl = slab + (size_t)(u.kt0() / nts) * (MS * D) + (size_t)(row0 - MP) * D + col0;
#pragma unroll
            for (int ai = 0; ai < 2; ++ai)
#pragma unroll
                for (int m = 0; m < 4; ++m)
#pragma unroll
                    for (int bj = 0; bj < 2; ++bj) { float* q = sl + (size_t)(ai * 128 + m * 16) * D + bj * 128;
                        *(f32x4*)q = acc[ai][bj][m][0]; *(f32x4*)(q + 4) = acc[ai][bj][m][1]; }
            return;
        }
        f32x4 q0[2], q1[2];
#pragma unroll
        for (int it = 0; it < 2; ++it) { const int row = row0 + (it >> 3) * 128 + ((it >> 1) & 3) * 16;
            const float* rp = (row < MP ? resP + (size_t)row * D : resS + (size_t)(row - MP) * D) + col0 + (it & 1) * 128;
            q0[it] = *(const f32x4*)rp; q1[it] = *(const f32x4*)(rp + 4); }
        float sq = 0.f;
#pragma unroll
        for (int it = 0; it < 16; ++it) {
            const int ai = it >> 3, m = (it >> 1) & 3, bj = it & 1;
            const int row = row0 + ai * 128 + m * 16, c = col0 + bj * 128;
            const f32x4 r0 = q0[it & 1], r1 = q1[it & 1];
            if (it + 2 < 16) { const int it2 = it + 2; const int row2 = row0 + (it2 >> 3) * 128 + ((it2 >> 1) & 3) * 16;
                const float* rp = (row2 < MP ? resP + (size_t)row2 * D : resS + (size_t)(row2 - MP) * D) + col0 + (it2 & 1) * 128;
                q0[it & 1] = *(const f32x4*)rp; q1[it & 1] = *(const f32x4*)(rp + 4); }
            const f32x4 v0 = r0 + scale * acc[ai][bj][m][0], v1 = r1 + scale * acc[ai][bj][m][1];
            *(f32x4*)(XR + (size_t)row * D + c) = v0; *(f32x4*)(XR + (size_t)row * D + c + 4) = v1;
            sq += v0.x * v0.x + v0.y * v0.y + v0.z * v0.z + v0.w * v0.w + v1.x * v1.x + v1.y * v1.y + v1.z * v1.z + v1.w * v1.w;
            if (XBo) { u32x4 w; w.x = cvt_pk_bf16(v0.x, v0.y); w.y = cvt_pk_bf16(v0.z, v0.w); w.z = cvt_pk_bf16(v1.x, v1.y); w.w = cvt_pk_bf16(v1.z, v1.w);
                *(u32x4*)(XBo + (size_t)row * D + c) = w; }
            if (bj == 1) { if (ssn) { const float tot = xsum_quads(sq); if (fq == 0) atomicAdd(ssn + row, tot); } sq = 0.f; }
        }
    }
};
struct EpiIn {
    static constexpr bool PERM = true;
    bf16_t* PR; bf16_t* PA; const float* ss; float* out;
    __device__ __forceinline__ void operator()(const f32x4 (&acc)[2][2][4][2], const pg8::Unit& u, int wr, int wc, int fr, int fq) const {
        const int row0 = u.pm * 256 + wr * 64 + fr, col0 = u.pn() * 256 + wc * 32 + 8 * fq;
        const int pn = u.pn();
#pragma unroll
        for (int ai = 0; ai < 2; ++ai)
#pragma unroll
            for (int m = 0; m < 4; ++m) {
                const int row = row0 + ai * 128 + m * 16;
                const float rs = rsqrtf(ss[row] * (1.f / 1024.f) + NORM_EPS);
#pragma unroll
                for (int bj = 0; bj < 2; ++bj) {
                    const int c = col0 + bj * 128;
                    const f32x4 v0 = acc[ai][bj][m][0] * rs, v1 = acc[ai][bj][m][1] * rs;
                    u32x4 w; w.x = cvt_pk_bf16(v0.x, v0.y); w.y = cvt_pk_bf16(v0.z, v0.w); w.z = cvt_pk_bf16(v1.x, v1.y); w.w = cvt_pk_bf16(v1.z, v1.w);
                    float* fo = nullptr;
                    if (pn < 7) {
                        *(u32x4*)(PR + (size_t)row * RC + c) = w;
                        if (row < MP) { if ((row & (SEQ - 1)) == SEQ - 1) fo = out + O_PSH + (size_t)(row >> 13) * RC + c; }
                        else { const int r = row - MP; if ((r & 15) == 15) fo = out + O_SSH + (size_t)(r >> 4) * RC + c; }
                    } else {
                        const int ca = c - RC;
                        *(u32x4*)(PA + (size_t)row * AC + ca) = w;
                        if (pn >= 9) {
                            const int cc = ca - 512, isv = cc >> 9, c2 = cc & 511, h = c2 >> 6, d = c2 & 63;
                            if (row < MP) { const int t = row & (SEQ - 1), b = row >> 13;
                                if (t >= SEQ - 512) fo = out + (isv ? O_PV : O_PK) + ((size_t)(b * 8 + h) * 512 + (t - (SEQ - 512))) * 64 + d; }
                            else { const int r = row - MP, sb = r >> 4, st = r & 15;
                                fo = out + (isv ? O_SV : O_SK) + ((size_t)(sb * 8 + h) * 16 + st) * 64 + d; }
                        }
                    }
                    if (fo) { *(f32x4*)fo = v0; *(f32x4*)(fo + 4) = v1; }
                }
            }
    }
};

__device__ __forceinline__ void tr_item(const float* W, int K, int N, bf16_t* WT, const float* scale, int mode, LAS float* scr, int item, int lane) {
    const int nblk = N / 32, kb = item / nblk, nb = item % nblk, k0 = 64 * kb, n0 = 32 * nb;
#pragma unroll 8
    for (int i = 0; i < 32; ++i) { const int kk = 2 * i + (lane >> 5); float v = W[(size_t)(k0 + kk) * N + n0 + (lane & 31)]; if (scale) v *= scale[k0 + kk]; scr[kk * 33 + (lane & 31)] = v; }
    asm volatile("s_waitcnt lgkmcnt(0)" ::: "memory");
    const int c = lane & 7;
#pragma unroll
    for (int j = 0; j < 4; ++j) { const int n = (lane >> 3) + 8 * j; const LAS float* s = scr + (8 * c) * 33 + n;
        u32x4 o; o.x = cvt_pk_bf16(s[0 * 33], s[1 * 33]); o.y = cvt_pk_bf16(s[2 * 33], s[3 * 33]); o.z = cvt_pk_bf16(s[4 * 33], s[5 * 33]); o.w = cvt_pk_bf16(s[6 * 33], s[7 * 33]);
        const int ng = n0 + n; const int rr = mode == 0 ? ng : (((ng >> 7) << 8) + (ng & 127) + (mode == 2 ? 128 : 0));
        *(u32x4*)(WT + (size_t)rr * K + k0 + 8 * c) = o; }
    asm volatile("s_waitcnt lgkmcnt(0)" ::: "memory");
}

struct Params { const float* in[30]; float* out; unsigned char* ws; int ph_lo, ph_hi; };

__device__ __forceinline__ void phase0(const Params& p, LAS unsigned char* lds, int gw, int NGW, int wave, int lane) {
    unsigned char* ws = p.ws;
    LAS float* scr = (LAS float*)(lds + wave * 8448);
    constexpr int I_GU = (D / 64) * (FF / 32), I_DN = (FF / 64) * (D / 32), I_IN = (D / 64) * (NIN / 32), I_OUT = (D / 64) * (D / 32), I_L = 16, I_GL = 32;
    constexpr int NITEMS = 4 * I_GU + 2 * I_DN + I_IN + I_OUT + 2 * I_L + I_GL;
    for (int it = gw; it < NITEMS; it += NGW) {
        int r = it;
        if (r < I_GU) { tr_item(p.in[7], D, FF, (bf16_t*)(ws + WS_WGU1), p.in[6], 1, scr, r, lane); continue; } r -= I_GU;
        if (r < I_GU) { tr_item(p.in[8], D, FF, (bf16_t*)(ws + WS_WGU1), p.in[6], 2, scr, r, lane); continue; } r -= I_GU;
        if (r < I_DN) { tr_item(p.in[9], FF, D, (bf16_t*)(ws + WS_WD1), nullptr, 0, scr, r, lane); continue; } r -= I_DN;
        if (r < I_IN) { tr_item(p.in[11], D, NIN, (bf16_t*)(ws + WS_WIN), p.in[10], 0, scr, r, lane); continue; } r -= I_IN;
        if (r < I_OUT) { tr_item(p.in[24], D, D, (bf16_t*)(ws + WS_WOUT), nullptr, 0, scr, r, lane); continue; } r -= I_OUT;
        if (r < I_GU) { tr_item(p.in[26], D, FF, (bf16_t*)(ws + WS_WGU2), p.in[25], 1, scr, r, lane); continue; } r -= I_GU;
        if (r < I_GU) { tr_item(p.in[27], D, FF, (bf16_t*)(ws + WS_WGU2), p.in[25], 2, scr, r, lane); continue; } r -= I_GU;
        if (r < I_DN) { tr_item(p.in[28], FF, D, (bf16_t*)(ws + WS_WD2), nullptr, 0, scr, r, lane); continue; } r -= I_DN;
        if (r < I_L) { tr_item(p.in[14], 64, 512, (bf16_t*)(ws + WS_WL), nullptr, 0, scr, r, lane); continue; } r -= I_L;
        if (r < I_L) { tr_item(p.in[16], 64, 512, (bf16_t*)(ws + WS_AL), nullptr, 0, scr, r, lane); continue; } r -= I_L;
        tr_item(p.in[17], 128, 512, (bf16_t*)(ws + WS_GL), nullptr, 0, scr, r, lane);
    }
    bf16_t* XB = (bf16_t*)(ws + WS_XB);
    float* SLAB = (float*)(ws + WS_SLAB);
    float* ss1 = (float*)(ws + WS_SS1);
    for (int m = gw; m < M; m += NGW) {
        const float* xrow = m < MP ? p.in[0] + (size_t)m * D : p.in[1] + (size_t)(m - MP) * D;
        const f32x4* xr = (const f32x4*)xrow + lane;
        f32x4 v[4]; float s = 0.f;
#pragma unroll
        for (int j = 0; j < 4; ++j) { v[j] = xr[64 * j]; s += v[j].x * v[j].x + v[j].y * v[j].y + v[j].z * v[j].z + v[j].w * v[j].w; }
        s = wave_sum(s);
        if (lane == 0) ss1[m] = s;
        if (m >= MP) { f32x4* xo = (f32x4*)(p.out + (size_t)m * D) + lane;
#pragma unroll
            for (int j = 0; j < 4; ++j) xo[64 * j] = v[j]; }
        u32x2* o8 = (u32x2*)(XB + (size_t)m * D) + lane;
#pragma unroll
        for (int j = 0; j < 4; ++j) { u32x2 o; o.x = cvt_pk_bf16(v[j].x, v[j].y); o.y = cvt_pk_bf16(v[j].z, v[j].w); o8[64 * j] = o; }
    }
    float* ssz = (float*)(ws + WS_SS2);
    for (int i = gw * 64 + lane; i < 3 * M; i += NGW * 64) ssz[i] = 0.f;
}

__device__ __forceinline__ float ld_prev(const bf16_t* PR, const float* sshift, int row, int col) {
    if (row < MP) { if ((row & (SEQ - 1)) == 0) return 0.f; return bf2f(PR[(size_t)(row - 1) * RC + col]); }
    const int r = row - MP; if ((r & 15) == 0) return sshift[(size_t)(r >> 4) * RC + col];
    return bf2f(PR[(size_t)(row - 1) * RC + col]);
}
__device__ __forceinline__ void up8(const u32x4 u, float (&f)[8]) { f[0] = bflo(u.x); f[1] = bfhi(u.x); f[2] = bflo(u.y); f[3] = bfhi(u.y); f[4] = bflo(u.z); f[5] = bfhi(u.z); f[6] = bflo(u.w); f[7] = bfhi(u.w); }
__device__ __forceinline__ void ld8f(const float* p, float (&f)[8]) { const f32x4 a = *(const f32x4*)p, b = *(const f32x4*)(p + 4); f[0] = a.x; f[1] = a.y; f[2] = a.z; f[3] = a.w; f[4] = b.x; f[5] = b.y; f[6] = b.z; f[7] = b.w; }
__device__ __forceinline__ u32x4 pk8(const float (&o)[8]) { u32x4 w; w.x = cvt_pk_bf16(o[0], o[1]); w.y = cvt_pk_bf16(o[2], o[3]); w.z = cvt_pk_bf16(o[4], o[5]); w.w = cvt_pk_bf16(o[6], o[7]); return w; }
constexpr int LW_PITCH = 144, LG_PITCH = 272, LW_OFF = 0, LA_OFF = 64 * LW_PITCH, LGL_OFF = 2 * 64 * LW_PITCH;
constexpr int PT_OFF = 36864;
constexpr int PT_MU = 0, PT_W0 = 1792, PT_A0 = 2304, PT_KK = 2816, PT_KA = 3328, PT_RK = 3840, PT_N = 4352;
__device__ __forceinline__ void prep_load_params(LAS unsigned char* lds, const Params& p, int tid) {
    LAS float* PT = (LAS float*)(lds + PT_OFF);
    for (int i = tid; i < PT_N; i += 512) {
        float v;
        if (i < PT_W0) v = p.in[12][i]; else if (i < PT_A0) v = p.in[13][i - PT_W0]; else if (i < PT_KK) v = p.in[15][i - PT_A0];
        else if (i < PT_KA) v = p.in[18][i - PT_KK]; else if (i < PT_RK) v = p.in[19][i - PT_KA]; else v = p.in[20][i - PT_RK];
        PT[i] = v;
    }
    __syncthreads();
}
__device__ __forceinline__ void lds8f(const LAS float* q, float (&f)[8]) { const f32x4 a = *(const LAS f32x4*)q, b = *(const LAS f32x4*)(q + 4); f[0] = a.x; f[1] = a.y; f[2] = a.z; f[3] = a.w; f[4] = b.x; f[5] = b.y; f[6] = b.z; f[7] = b.w; }
__device__ __forceinline__ void prep_unit(LAS unsigned char* lds, const Params& p, int u, int lane, int tid, int h_lo, int h_hi) {
    unsigned char* ws = p.ws;
    const bf16_t* PR = (const bf16_t*)(ws + WS_PR);
    const float* sshift = p.in[2];
    const LAS float* PT = (const LAS float*)(lds + PT_OFF);
    const bf16_t* WL = (const bf16_t*)(ws + WS_WL); const bf16_t* AL = (const bf16_t*)(ws + WS_AL); const bf16_t* GL = (const bf16_t*)(ws + WS_GL);
    float* SW = (float*)(ws + WS_XB);
    bf16_t* SR = (bf16_t*)(ws + WS_S5); bf16_t* SK = (bf16_t*)(ws + WS_S5 + S5B); bf16_t* SV = (bf16_t*)(ws + WS_S5 + 2 * S5B);
    bf16_t* SKK = (bf16_t*)(ws + WS_S5 + 3 * S5B); bf16_t* SB = (bf16_t*)(ws + WS_S5 + 4 * S5B); bf16_t* SG = (bf16_t*)(ws + WS_G);
    float* BON = (float*)(ws + WS_BON);
    const int row0 = u * 16, i16 = lane & 15, quad = lane >> 4;
    const int row = row0 + i16;
    const bool zero_prev = row < MP && (row & (SEQ - 1)) == 0;
    const bool st_prev = row >= MP && ((row - MP) & 15) == 0;
    const bf16_t* prow = PR + (size_t)row * RC;
    const bf16_t* pprev = PR + (size_t)(zero_prev || st_prev ? row : row - 1) * RC;
    const float* sprev = sshift + (size_t)(st_prev ? ((row - MP) >> 4) : 0) * RC;
    auto lerp8 = [&](const u32x4 cu, const u32x4 pu, int col, float (&x)[8]) {
        float cf[8], pf[8], mf[8];
        up8(cu, cf);
        if (st_prev) ld8f(sprev + col, pf); else up8(pu, pf);
        lds8f(PT + PT_MU + col, mf);
#pragma unroll
        for (int j = 0; j < 8; ++j) { const float pv = zero_prev ? 0.f : pf[j]; x[j] = cf[j] + (pv - cf[j]) * mf[j]; }
    };
    bf16x8 Bf[8];
    {
        u32x4 cu[8], pu[8];
#pragma unroll
        for (int s8 = 0; s8 < 8; ++s8) { const int col = 1536 + s8 * 32 + quad * 8; cu[s8] = *(const u32x4*)(prow + col); pu[s8] = *(const u32x4*)(pprev + col); }
#pragma unroll
        for (int s8 = 0; s8 < 8; ++s8) {
            float xv[8]; lerp8(cu[s8], pu[s8], 1536 + s8 * 32 + quad * 8, xv);
#pragma unroll
            for (int j = 0; j < 8; ++j) {
                if (s8 < 2) xv[j] = 1.f - 2.f * __builtin_amdgcn_rcpf(1.f + fast_exp(2.f * xv[j]));
                else if (s8 >= 4) xv[j] = sigmoidf_(xv[j]);
            }
            Bf[s8] = __builtin_bit_cast(bf16x8, pk8(xv));
        }
    }
#pragma unroll 1
    for (int h = h_lo; h < h_hi; ++h) {
        __syncthreads();
        { const int r = tid >> 3, ch = tid & 7;
          *(LAS u32x4*)(lds + LW_OFF + r * LW_PITCH + ch * 16) = *(const u32x4*)(WL + (size_t)(h * 64 + r) * 64 + ch * 8);
          *(LAS u32x4*)(lds + LA_OFF + r * LW_PITCH + ch * 16) = *(const u32x4*)(AL + (size_t)(h * 64 + r) * 64 + ch * 8);
#pragma unroll
          for (int i = 0; i < 2; ++i) { const int pz = tid + 512 * i, rr = pz >> 4, c2 = pz & 15;
              *(LAS u32x4*)(lds + LGL_OFF + rr * LG_PITCH + c2 * 16) = *(const u32x4*)(GL + (size_t)(h * 64 + rr) * 128 + c2 * 8); } }
        __syncthreads();
        float ssq = 0.f, bs = 0.f;
#pragma unroll 1
        for (int g2 = 0; g2 < 2; ++g2) {
            const int cbase = h * 64 + g2 * 32;
            const int c0 = cbase + 8 * quad;
            const size_t o = (size_t)row * RW + c0;
            const u32x4 rcu = *(const u32x4*)(prow + c0), kcu = *(const u32x4*)(prow + 512 + c0), vcu = *(const u32x4*)(prow + 1024 + c0);
            const u32x4 rpu = *(const u32x4*)(pprev + c0), kpu = *(const u32x4*)(pprev + 512 + c0), vpu = *(const u32x4*)(pprev + 1024 + c0);
            f32x4 aW[2], aA[2], aG[2];
#pragma unroll
            for (int t = 0; t < 2; ++t) {
                const int rl = g2 * 32 + 8 * (i16 >> 2) + 4 * t + (i16 & 3);
                aW[t] = (f32x4){0.f, 0.f, 0.f, 0.f}; aA[t] = aW[t]; aG[t] = aW[t];
#pragma unroll
                for (int ks = 0; ks < 2; ++ks) {
                    const bf16x8 fw = *(const LAS bf16x8*)(lds + LW_OFF + rl * LW_PITCH + (ks * 32 + quad * 8) * 2);
                    const bf16x8 fa = *(const LAS bf16x8*)(lds + LA_OFF + rl * LW_PITCH + (ks * 32 + quad * 8) * 2);
                    aW[t] = __builtin_amdgcn_mfma_f32_16x16x32_bf16(fw, Bf[ks], aW[t], 0, 0, 0);
                    aA[t] = __builtin_amdgcn_mfma_f32_16x16x32_bf16(fa, Bf[2 + ks], aA[t], 0, 0, 0);
                }
#pragma unroll
                for (int ks = 0; ks < 4; ++ks) {
                    const bf16x8 fg = *(const LAS bf16x8*)(lds + LGL_OFF + rl * LG_PITCH + (ks * 32 + quad * 8) * 2);
                    aG[t] = __builtin_amdgcn_mfma_f32_16x16x32_bf16(fg, Bf[4 + ks], aG[t], 0, 0, 0);
                }
            }
            float gg[8], dec[8], av[8], k4[8], kru[8], kbu[8], rs[8], vs[8];
#pragma unroll
            for (int e = 0; e < 8; ++e) gg[e] = aG[e >> 2][e & 3];
            { float w0v[8]; lds8f(PT + PT_W0 + c0, w0v);
#pragma unroll
              for (int e = 0; e < 8; ++e) { const float z = -(w0v[e] + aW[e >> 2][e & 3]);
                  const float sp = fmaxf(z, 0.f) + __logf(1.f + fast_exp(-fabsf(z)));
                  dec[e] = fast_exp(-fast_exp(-sp - 0.5f)); } }
            { float a0v[8]; lds8f(PT + PT_A0 + c0, a0v);
#pragma unroll
              for (int e = 0; e < 8; ++e) av[e] = sigmoidf_(a0v[e] + aA[e >> 2][e & 3]); }
            { float ks_[8], kkv[8], kav[8]; lerp8(kcu, kpu, 512 + c0, ks_); lds8f(PT + PT_KK + c0, kkv); lds8f(PT + PT_KA + c0, kav);
#pragma unroll
              for (int e = 0; e < 8; ++e) { const float kr = ks_[e] * kkv[e]; kru[e] = kr; kbu[e] = kr * av[e]; ssq += kr * kr; k4[e] = ks_[e] * (1.f + (av[e] - 1.f) * kav[e]); } }
            { float rkv[8]; lerp8(rcu, rpu, c0, rs); lds8f(PT + PT_RK + c0, rkv);
#pragma unroll
              for (int e = 0; e < 8; ++e) bs += rs[e] * k4[e] * rkv[e]; }
            lerp8(vcu, vpu, 1024 + c0, vs);
            *(u32x4*)(SG + o) = pk8(gg);
            *(f32x4*)(SW + o) = (f32x4){dec[0], dec[1], dec[2], dec[3]}; *(f32x4*)(SW + o + 4) = (f32x4){dec[4], dec[5], dec[6], dec[7]};
            *(u32x4*)(SK + o) = pk8(k4); *(u32x4*)(SKK + o) = pk8(kru); *(u32x4*)(SB + o) = pk8(kbu);
            *(u32x4*)(SR + o) = pk8(rs); *(u32x4*)(SV + o) = pk8(vs);
        }
        ssq += __shfl_xor(ssq, 16); ssq += __shfl_xor(ssq, 32);
        bs += __shfl_xor(bs, 16); bs += __shfl_xor(bs, 32);
        if (quad == 0) { BON[(size_t)row * 8 + h] = bs; ((float*)(ws + WS_INV))[(size_t)row * 8 + h] = rsqrtf(fmaxf(ssq, 1e-24f)); }
    }
}

__device__ __forceinline__ bf16x8 tr_read2(unsigned a0, unsigned a1) {
    u32x2 r0, r1;
    asm volatile("ds_read_b64_tr_b16 %0, %2\n\tds_read_b64_tr_b16 %1, %3\n\ts_waitcnt lgkmcnt(0)" : "=&v"(r0), "=&v"(r1) : "v"(a0), "v"(a1) : "memory");
    u32x4 w; w.x = r0.x; w.y = r0.y; w.z = r1.x; w.w = r1.y;
    return __builtin_bit_cast(bf16x8, w);
}
__device__ __forceinline__ void tr_read8(unsigned a, bf16x8 (&Av)[4]) {
    u32x2 r0, r1, r2, r3, r4, r5, r6, r7;
    asm volatile("ds_read_b64_tr_b16 %0, %8\n\tds_read_b64_tr_b16 %1, %8 offset:2304\n\t"
                 "ds_read_b64_tr_b16 %2, %8 offset:32\n\tds_read_b64_tr_b16 %3, %8 offset:2336\n\t"
                 "ds_read_b64_tr_b16 %4, %8 offset:64\n\tds_read_b64_tr_b16 %5, %8 offset:2368\n\t"
                 "ds_read_b64_tr_b16 %6, %8 offset:96\n\tds_read_b64_tr_b16 %7, %8 offset:2400\n\ts_waitcnt lgkmcnt(0)"
                 : "=&v"(r0), "=&v"(r1), "=&v"(r2), "=&v"(r3), "=&v"(r4), "=&v"(r5), "=&v"(r6), "=&v"(r7) : "v"(a) : "memory");
    u32x4 w;
    w.x = r0.x; w.y = r0.y; w.z = r1.x; w.w = r1.y; Av[0] = __builtin_bit_cast(bf16x8, w);
    w.x = r2.x; w.y = r2.y; w.z = r3.x; w.w = r3.y; Av[1] = __builtin_bit_cast(bf16x8, w);
    w.x = r4.x; w.y = r4.y; w.z = r5.x; w.w = r5.y; Av[2] = __builtin_bit_cast(bf16x8, w);
    w.x = r6.x; w.y = r6.y; w.z = r7.x; w.w = r7.y; Av[3] = __builtin_bit_cast(bf16x8, w);
}
constexpr int ATT_WL = 10496, VPITCH = 144;
constexpr int QT = 2;
__device__ __forceinline__ void attn_prompt_unit(LAS unsigned char* wl, bf16_t* PA, const float* relb, int u, int lane) {
    const int h = u & 7, qh = (u >> 3) & 1, cb = u >> 4, c = cb & 127, b = cb >> 7;
    const int i16 = lane & 15, quad = lane >> 4;
    const size_t c0 = (size_t)b * SEQ + (size_t)c * 64;
    const size_t q0 = c0 + qh * 32;
    LAS float* tab = (LAS float*)(wl + 9216);
    const float tab0 = relb[h * 257] * 1.44269504089f;
    bf16x8 Bq[QT][2];
#pragma unroll
    for (int qt = 0; qt < QT; ++qt)
#pragma unroll
        for (int ks = 0; ks < 2; ++ks) Bq[qt][ks] = *(const bf16x8*)(PA + (q0 + qt * 16 + i16) * AC + h * 64 + ks * 32 + quad * 8);
    f32x4 O[4][QT];
    float mrun[QT], lrun[QT];
#pragma unroll
    for (int qt = 0; qt < QT; ++qt) { mrun[qt] = -1e30f; lrun[qt] = 0.f;
#pragma unroll
        for (int dt = 0; dt < 4; ++dt) O[dt][qt] = (f32x4){0.f, 0.f, 0.f, 0.f}; }
    const unsigned wbase = (unsigned)(unsigned long)wl;
    const int kt0 = (c < 8 ? 8 - c : 0);
    bf16x8 Kc[4][2]; u32x4 Vc[8];
    auto issue_tile = [&](int kt, bf16x8 (&Kx)[4][2], u32x4 (&Vx)[8]) {
        const size_t k0 = c0 - (size_t)(8 - kt) * 64;
#pragma unroll
        for (int kti = 0; kti < 4; ++kti) { const bf16_t* kp = PA + (k0 + kti * 16 + i16) * AC + 512 + h * 64 + quad * 8;
            Kx[kti][0] = *(const bf16x8*)kp; Kx[kti][1] = *(const bf16x8*)(kp + 32); }
#pragma unroll
        for (int i = 0; i < 8; ++i) { const int pz = lane + 64 * i, key = pz >> 3, ch = pz & 7;
            Vx[i] = *(const u32x4*)(PA + (k0 + key) * AC + 1024 + h * 64 + ch * 8); }
    };
    issue_tile(kt0, Kc, Vc);
    for (int kt = kt0; kt <= 8; ++kt) {
#pragma unroll
        for (int i = 0; i < 8; ++i) { const int pz = lane + 64 * i, key = pz >> 3, ch = pz & 7; *(LAS u32x4*)(wl + key * VPITCH + ch * 16) = Vc[i]; }
        bf16x8 Ku[4][2];
#pragma unroll
        for (int kti = 0; kti < 4; ++kti) { Ku[kti][0] = Kc[kti][0]; Ku[kti][1] = Kc[kti][1]; }
        if (kt < 8) issue_tile(kt + 1, Kc, Vc);
        f32x4 St[4][QT];
#pragma unroll
        for (int kti = 0; kti < 4; ++kti) {
#pragma unroll
            for (int qt = 0; qt < QT; ++qt) {
                f32x4 s = {0.f, 0.f, 0.f, 0.f};
                s = __builtin_amdgcn_mfma_f32_16x16x32_bf16(Ku[kti][0], Bq[qt][0], s, 0, 0, 0);
                s = __builtin_amdgcn_mfma_f32_16x16x32_bf16(Ku[kti][1], Bq[qt][1], s, 0, 0, 0);
                St[kti][qt] = s;
            }
        }
        const float sc = 0.125f * 1.44269504089f;
        if (kt < 6) {
#pragma unroll
            for (int kti = 0; kti < 4; ++kti)
#pragma unroll
                for (int qt = 0; qt < QT; ++qt) St[kti][qt] = St[kti][qt] * sc + tab0;
        } else {
#pragma unroll
            for (int kti = 0; kti < 4; ++kti)
#pragma unroll
                for (int qt = 0; qt < QT; ++qt)
#pragma unroll
                    for (int j = 0; j < 4; ++j) {
                        int rel = (kt - 8) * 64 + kti * 16 + quad * 4 + j - (qh * 32 + qt * 16 + i16);
                        rel = rel < -128 ? -128 : (rel > 128 ? 128 : rel);
                        St[kti][qt][j] = St[kti][qt][j] * sc + tab[rel + 128];
                    }
        }
#pragma unroll
        for (int qt = 0; qt < QT; ++qt) {
            float mx = -1e30f;
#pragma unroll
            for (int kti = 0; kti < 4; ++kti)
#pragma unroll
                for (int j = 0; j < 4; ++j) mx = fmaxf(mx, St[kti][qt][j]);
            mx = xmax_quads(mx);
            const float mnew = fmaxf(mrun[qt], mx);
            const float alpha = __builtin_amdgcn_exp2f(mrun[qt] - mnew);
            mrun[qt] = mnew;
            float ps = 0.f;
#pragma unroll
            for (int kti = 0; kti < 4; ++kti)
#pragma unroll
                for (int j = 0; j < 4; ++j) { const float pv = __builtin_amdgcn_exp2f(St[kti][qt][j] - mnew); St[kti][qt][j] = pv; ps += pv; }
            lrun[qt] = lrun[qt] * alpha + ps;
#pragma unroll
            for (int dt = 0; dt < 4; ++dt) O[dt][qt] = O[dt][qt] * alpha;
        }
#pragma unroll
        for (int ks2 = 0; ks2 < 2; ++ks2) {
            bf16x8 Bp[QT];
#pragma unroll
            for (int qt = 0; qt < QT; ++qt) {
                u32x4 w; const f32x4 p0 = St[2 * ks2][qt], p1 = St[2 * ks2 + 1][qt];
                w.x = cvt_pk_bf16(p0.x, p0.y); w.y = cvt_pk_bf16(p0.z, p0.w); w.z = cvt_pk_bf16(p1.x, p1.y); w.w = cvt_pk_bf16(p1.z, p1.w);
                Bp[qt] = __builtin_bit_cast(bf16x8, w);
            }
            bf16x8 Av[4];
            tr_read8(wbase + (unsigned)((32 * ks2 + 4 * quad + (i16 >> 2)) * VPITCH + (4 * (lane & 3)) * 2), Av);
#pragma unroll
            for (int dt = 0; dt < 4; ++dt)
#pragma unroll
                for (int qt = 0; qt < QT; ++qt) O[dt][qt] = __builtin_amdgcn_mfma_f32_16x16x32_bf16(Av[dt], Bp[qt], O[dt][qt], 0, 0, 0);
        }
    }
#pragma unroll
    for (int qt = 0; qt < QT; ++qt) {
        const float l = xsum_quads(lrun[qt]);
        const float inv = 1.f / l;
#pragma unroll
        for (int dt = 0; dt < 4; ++dt) {
            const f32x4 o = O[dt][qt] * inv;
            u32x2 w; w.x = cvt_pk_bf16(o.x, o.y); w.y = cvt_pk_bf16(o.z, o.w);
            *(u32x2*)(PA + (q0 + qt * 16 + i16) * AC + h * 64 + dt * 16 + quad * 4) = w;
        }
    }
}
__device__ __forceinline__ void attn_sample_unit(LAS unsigned char* wl, const Params& p, int u, int lane) {
    bf16_t* PA = (bf16_t*)(p.ws + WS_PA);
    const int i = u & 15, h = (u >> 4) & 7, sb = u >> 7;
    const size_t qrow = (size_t)MP + sb * 16 + i;
    LAS float* qs = (LAS float*)wl; LAS float* pb = (LAS float*)(wl + 256);
    qs[lane] = bf2f(PA[qrow * AC + h * 64 + lane]);
    const float* ck = p.in[4] + (size_t)(sb * 8 + h) * 512 * 64; const float* cv = p.in[5] + (size_t)(sb * 8 + h) * 512 * 64;
    const float* nk = p.out + O_SK + (size_t)(sb * 8 + h) * 16 * 64; const float* nv = p.out + O_SV + (size_t)(sb * 8 + h) * 16 * 64;
    const float* tabg = p.in[23] + h * 257;
    float mx = -1e30f;
#pragma unroll 1
    for (int ps = 0; ps < 9; ++ps) {
        const int j = ps * 64 + lane;
        if (j < 528) {
            const float* kr = j < 512 ? ck + (size_t)j * 64 : nk + (size_t)(j - 512) * 64;
            float a = 0.f;
#pragma unroll
            for (int d = 0; d < 64; d += 4) { const f32x4 kv = *(const f32x4*)(kr + d); const f32x4 qv = *(const LAS f32x4*)(qs + d); a += kv.x * qv.x + kv.y * qv.y + kv.z * qv.z + kv.w * qv.w; }
            int rel = j - 512 - i; rel = rel < -128 ? -128 : (rel > 128 ? 128 : rel);
            const float s = a * 0.125f + tabg[rel + 128];
            pb[j] = s; mx = fmaxf(mx, s);
        }
    }
    mx = wave_max(mx);
    float sum = 0.f;
#pragma unroll 1
    for (int ps = 0; ps < 9; ++ps) { const int j = ps * 64 + lane; if (j < 528) { const float e = fast_exp(pb[j] - mx); sum += e; pb[j] = e; } }
    sum = wave_sum(sum);
    float o = 0.f;
    float o1 = 0.f, o2 = 0.f, o3 = 0.f;
#pragma unroll 8
    for (int j = 0; j < 512; j += 4) { o += pb[j] * cv[(size_t)j * 64 + lane]; o1 += pb[j + 1] * cv[(size_t)(j + 1) * 64 + lane]; o2 += pb[j + 2] * cv[(size_t)(j + 2) * 64 + lane]; o3 += pb[j + 3] * cv[(size_t)(j + 3) * 64 + lane]; }
#pragma unroll
    for (int j = 0; j < 16; ++j) o += pb[512 + j] * nv[(size_t)j * 64 + lane];
    o += o1 + o2 + o3;
    PA[qrow * AC + h * 64 + lane] = f2bf(o / sum);
}

constexpr int STEP_B = 1344;
template <int NS>
__device__ __forceinline__ void scan_unit(LAS unsigned char* lds, const Params& p, size_t row0, int T, int h, int vq, const float* s_init, float* s_out, int tid) {
    unsigned char* ws = p.ws;
    const float* SW = (const float*)(ws + WS_XB);
    const bf16_t* SR = (const bf16_t*)(ws + WS_S5); const bf16_t* SK = (const bf16_t*)(ws + WS_S5 + S5B); const bf16_t* SV = (const bf16_t*)(ws + WS_S5 + 2 * S5B);
    const bf16_t* SKK = (const bf16_t*)(ws + WS_S5 + 3 * S5B); const bf16_t* SB = (const bf16_t*)(ws + WS_S5 + 4 * S5B);
    float* Y = (float*)(ws + WS_PR);
    constexpr int BUF_B = NS * STEP_B;
    LAS unsigned char* ybase = lds + 2 * 32 * STEP_B;
    const int nchunks = T / NS;
    const bool loader = tid >= 256;
    const int L = tid - 256;
    const int lane = tid & 63, wv = tid >> 6, vi = lane >> 4, kj = lane & 15, rloc = wv * 4 + vi;
    f32x2 S01 = {0.f, 0.f}, S23 = {0.f, 0.f};
    if (!loader && s_init) { const f32x4 s = *(const f32x4*)(s_init + (size_t)(vq * 16 + rloc) * 64 + 4 * kj); S01 = (f32x2){s.x, s.y}; S23 = (f32x2){s.z, s.w}; }
    f32x4 gw_[(NS * 16 + 255) / 256]; u32x4 gkk = {0u, 0u, 0u, 0u}, gb = gkk, gk = gkk, gr = gkk, gv = gkk; float ginv = 0.f;
    const float* INV = (const float*)(ws + WS_INV);
#pragma unroll
    for (int i = 0; i < (NS * 16 + 255) / 256; ++i) gw_[i] = (f32x4){0.f, 0.f, 0.f, 0.f};
    auto issue_chunk = [&](int c) {
        const size_t r0 = row0 + (size_t)c * NS;
#pragma unroll
        for (int i = 0; i < (NS * 16 + 255) / 256; ++i) { const int pz = L + 256 * i; if (pz < NS * 16) { const int st = pz >> 4, o = pz & 15;
            gw_[i] = *(const f32x4*)(SW + (r0 + st) * RW + h * 64 + o * 4); } }
        if (L < NS * 8) { const int st = L >> 3, o = L & 7; const size_t g = (r0 + st) * RW + h * 64 + o * 8;
            gkk = *(const u32x4*)(SKK + g); gb = *(const u32x4*)(SB + g); gk = *(const u32x4*)(SK + g); gr = *(const u32x4*)(SR + g); ginv = INV[(r0 + st) * 8 + h]; }
        if (L < NS * 2) { const int st = L >> 1, hf = L & 1; gv = *(const u32x4*)(SV + (r0 + st) * RW + h * 64 + vq * 16 + hf * 8); }
    };
    auto commit_chunk = [&](int c) {
        LAS unsigned char* buf = lds + (c & 1) * 32 * STEP_B;
#pragma unroll
        for (int i = 0; i < (NS * 16 + 255) / 256; ++i) { const int pz = L + 256 * i; if (pz < NS * 16) { const int st = pz >> 4, o = pz & 15;
            *(LAS f32x4*)(buf + st * STEP_B + o * 16) = gw_[i]; } }
        if (L < NS * 8) { const int st = L >> 3, o = L & 7;
            const u32x4 a = gkk, b = gb, k = gk, r = gr;
            LAS unsigned char* d = buf + st * STEP_B + o * 32;
            *(LAS f32x4*)(d + 256) = (f32x4){bflo(a.x), bfhi(a.x), bflo(a.y), bfhi(a.y)} * ginv; *(LAS f32x4*)(d + 256 + 16) = (f32x4){bflo(a.z), bfhi(a.z), bflo(a.w), bfhi(a.w)} * ginv;
            *(LAS f32x4*)(d + 512) = (f32x4){bflo(b.x), bfhi(b.x), bflo(b.y), bfhi(b.y)} * ginv; *(LAS f32x4*)(d + 512 + 16) = (f32x4){bflo(b.z), bfhi(b.z), bflo(b.w), bfhi(b.w)} * ginv;
            *(LAS f32x4*)(d + 768) = (f32x4){bflo(k.x), bfhi(k.x), bflo(k.y), bfhi(k.y)}; *(LAS f32x4*)(d + 768 + 16) = (f32x4){bflo(k.z), bfhi(k.z), bflo(k.w), bfhi(k.w)};
            *(LAS f32x4*)(d + 1024) = (f32x4){bflo(r.x), bfhi(r.x), bflo(r.y), bfhi(r.y)}; *(LAS f32x4*)(d + 1024 + 16) = (f32x4){bflo(r.z), bfhi(r.z), bflo(r.w), bfhi(r.w)}; }
        if (L < NS * 2) { const int st = L >> 1, hf = L & 1; const u32x4 v = gv;
            LAS unsigned char* d = buf + st * STEP_B + 1280 + hf * 32;
            *(LAS f32x4*)d = (f32x4){bflo(v.x), bfhi(v.x), bflo(v.y), bfhi(v.y)}; *(LAS f32x4*)(d + 16) = (f32x4){bflo(v.z), bfhi(v.z), bflo(v.w), bfhi(v.w)}; }
    };
    auto flush_y = [&](int c) {
        if (L < NS * 4) { const int st = L >> 2, q = L & 3; const f32x4 v = *(const LAS f32x4*)(ybase + (c & 1) * 2048 + st * 64 + q * 16);
            *(f32x4*)(Y + (row0 + (size_t)c * NS + st) * RW + h * 64 + vq * 16 + q * 4) = v; }
    };
#define SCAN_BAR() do { asm volatile("s_waitcnt lgkmcnt(0)" ::: "memory"); __builtin_amdgcn_s_barrier(); asm volatile("" ::: "memory"); } while (0)
    if (loader) { issue_chunk(0); commit_chunk(0); if (nchunks > 1) issue_chunk(1); }
    SCAN_BAR();
    for (int c = 0; c < nchunks; ++c) {
        if (loader) {
            if (c + 1 < nchunks) commit_chunk(c + 1);
            if (c + 2 < nchunks) issue_chunk(c + 2);
            if (c > 0) flush_y(c - 1);
        } else {
            LAS unsigned char* buf = lds + (c & 1) * 32 * STEP_B;
            LAS float* yb = (LAS float*)(ybase + (c & 1) * 2048);
            f32x4 w4 = *(const LAS f32x4*)(buf + kj * 16), kk4 = *(const LAS f32x4*)(buf + 256 + kj * 16), b4 = *(const LAS f32x4*)(buf + 512 + kj * 16),
                  k4 = *(const LAS f32x4*)(buf + 768 + kj * 16), r4 = *(const LAS f32x4*)(buf + 1024 + kj * 16);
            float vv = *(const LAS float*)(buf + 1280 + rloc * 4);
            float ykeep = 0.f, ypart = 0.f;
#pragma unroll
            for (int s = 0; s <= NS; ++s) {
                f32x4 w4n = w4, kk4n = kk4, b4n = b4, k4n = k4, r4n = r4; float vvn = vv;
                if (s + 1 < NS) { LAS unsigned char* sp = buf + (s + 1) * STEP_B;
                    w4n = *(const LAS f32x4*)(sp + kj * 16); kk4n = *(const LAS f32x4*)(sp + 256 + kj * 16); b4n = *(const LAS f32x4*)(sp + 512 + kj * 16);
                    k4n = *(const LAS f32x4*)(sp + 768 + kj * 16); r4n = *(const LAS f32x4*)(sp + 1024 + kj * 16); vvn = *(const LAS float*)(sp + 1280 + rloc * 4); }
                float sa = 0.f;
                if (s < NS) { f32x2 t = S01 * (f32x2){kk4.x, kk4.y}; t = S23 * (f32x2){kk4.z, kk4.w} + t; sa = t.x + t.y; }
                float yr = ypart;
                sa += dppf<0xB1>(sa); yr += dppf<0xB1>(yr);
                sa += dppf<0x4E>(sa); yr += dppf<0x4E>(yr);
                sa += dppf<0x141>(sa); yr += dppf<0x141>(yr);
                sa += dppf<0x140>(sa); yr += dppf<0x140>(yr);
                if (s > 0) { ykeep = (kj == ((s - 1) & 15)) ? yr : ykeep;
                    if (((s - 1) & 15) == 15) yb[((s - 1) - 15 + kj) * 16 + rloc] = ykeep; }
                if (s < NS) {
                    const f32x2 vk01 = (f32x2){vv, vv} * (f32x2){k4.x, k4.y}, vk23 = (f32x2){vv, vv} * (f32x2){k4.z, k4.w};
                    S01 = S01 * (f32x2){w4.x, w4.y} + vk01; S23 = S23 * (f32x2){w4.z, w4.w} + vk23;
                    const f32x2 nsa = {-sa, -sa};
                    S01 = nsa * (f32x2){b4.x, b4.y} + S01; S23 = nsa * (f32x2){b4.z, b4.w} + S23;
                    f32x2 yy = S01 * (f32x2){r4.x, r4.y}; yy = S23 * (f32x2){r4.z, r4.w} + yy;
                    ypart = yy.x + yy.y;
                }
                w4 = w4n; kk4 = kk4n; b4 = b4n; k4 = k4n; r4 = r4n; vv = vvn;
            }
        }
        SCAN_BAR();
    }
    if (loader) flush_y(nchunks - 1);
    else *(f32x4*)(s_out + (size_t)(vq * 16 + rloc) * 64 + 4 * kj) = (f32x4){S01.x, S01.y, S23.x, S23.y};
    SCAN_BAR();
#undef SCAN_BAR
}

__device__ __forceinline__ void post_row(const Params& p, int row, int lane) {
    unsigned char* ws = p.ws;
    const float* Y = (const float*)(ws + WS_PR); const bf16_t* PA = (const bf16_t*)(ws + WS_PA); const bf16_t* SV = (const bf16_t*)(ws + WS_S5 + 2 * S5B);
    const bf16_t* SG = (const bf16_t*)(ws + WS_G); const float* BON = (const float*)(ws + WS_BON); bf16_t* MIX = (bf16_t*)(ws + WS_S5);
    const int c0 = lane * 8, h = lane >> 3;
    const f32x4 y0 = *(const f32x4*)(Y + (size_t)row * RW + c0), y1 = *(const f32x4*)(Y + (size_t)row * RW + c0 + 4);
    float yv[8] = {y0.x, y0.y, y0.z, y0.w, y1.x, y1.y, y1.z, y1.w};
    float s = 0.f;
#pragma unroll
    for (int j = 0; j < 8; ++j) s += yv[j];
    const float mean = row8_sum(s) * (1.f / 64.f);
    float s2 = 0.f;
#pragma unroll
    for (int j = 0; j < 8; ++j) { yv[j] -= mean; s2 += yv[j] * yv[j]; }
    const float rstd = rsqrtf(row8_sum(s2) * (1.f / 64.f) + GN_EPS);
    const u32x4 vu = *(const u32x4*)(SV + (size_t)row * RW + c0), gu = *(const u32x4*)(SG + (size_t)row * RW + c0);
    const float vf[8] = {bflo(vu.x), bfhi(vu.x), bflo(vu.y), bfhi(vu.y), bflo(vu.z), bfhi(vu.z), bflo(vu.w), bfhi(vu.w)};
    const float gf[8] = {bflo(gu.x), bfhi(gu.x), bflo(gu.y), bfhi(gu.y), bflo(gu.z), bfhi(gu.z), bflo(gu.w), bfhi(gu.w)};
    const float bd = BON[(size_t)row * 8 + h];
    const float* lw = p.in[21] + c0; const float* lb = p.in[22] + c0;
    float o[8];
#pragma unroll
    for (int j = 0; j < 8; ++j) o[j] = (yv[j] * rstd * lw[j] + lb[j] + bd * vf[j]) * gf[j];
    u32x4 w; w.x = cvt_pk_bf16(o[0], o[1]); w.y = cvt_pk_bf16(o[2], o[3]); w.z = cvt_pk_bf16(o[4], o[5]); w.w = cvt_pk_bf16(o[6], o[7]);
    *(u32x4*)(MIX + (size_t)row * D + c0) = w;
    *(u32x4*)(MIX + (size_t)row * D + 512 + c0) = *(const u32x4*)(PA + (size_t)row * AC + c0);
}


__device__ __forceinline__ void rowss_phase(const float* XR, float* ss, int gw, int NGW, int lane) {
    for (int m = gw; m < M; m += NGW) {
        const f32x4* xr = (const f32x4*)(XR + (size_t)m * D) + lane; float s = 0.f;
#pragma unroll
        for (int j = 0; j < 4; ++j) { const f32x4 v = xr[64 * j]; s += v.x * v.x + v.y * v.y + v.z * v.z + v.w * v.w; }
        s = wave_sum(s);
        if (lane == 0) ss[m] = s;
    }
}

__device__ __forceinline__ void fix_sample_rows(float* XR, const float* slab, int nsl, float scale, float* ssn, bf16_t* XBo, int gw, int NGW, int lane) {
    for (int m = MP + gw; m < M; m += NGW) {
        f32x4* xr = (f32x4*)(XR + (size_t)m * D) + lane; f32x4 v[4], a[4]; float s = 0.f;
#pragma unroll
        for (int j = 0; j < 4; ++j) { v[j] = xr[64 * j]; a[j] = (f32x4){0.f, 0.f, 0.f, 0.f}; }
        for (int q = 0; q < nsl; ++q) { const f32x4* sp = (const f32x4*)(slab + (size_t)q * (MS * D) + (size_t)(m - MP) * D) + lane;
#pragma unroll
            for (int j = 0; j < 4; ++j) a[j] += sp[64 * j]; }
#pragma unroll
        for (int j = 0; j < 4; ++j) { v[j] += scale * a[j]; xr[64 * j] = v[j]; s += v[j].x * v[j].x + v[j].y * v[j].y + v[j].z * v[j].z + v[j].w * v[j].w; }
        s = wave_sum(s);
        if (ssn && lane == 0) ssn[m] = s;
        if (XBo) { u32x2* o8 = (u32x2*)(XBo + (size_t)m * D) + lane;
#pragma unroll
            for (int j = 0; j < 4; ++j) { u32x2 o; o.x = cvt_pk_bf16(v[j].x, v[j].y); o.y = cvt_pk_bf16(v[j].z, v[j].w); o8[64 * j] = o; } }
    }
}

#define XB_TMO      128
#define XB_XCNT(j)  (256  + 64 * (j))
#define XB_XSUB(j)  (1280 + 64 * (j))
#define XB_XGEN(j)  (2304 + 64 * (j))
#define XB_TOP      3328
#define XB_TOPGEN   3392
#define XCD_BAR_WORDS 3456
#define XB_SPIN_CAP (1u << 22)
__device__ __forceinline__ unsigned xb_ld(unsigned* p)              { return __hip_atomic_load(p, __ATOMIC_RELAXED, __HIP_MEMORY_SCOPE_AGENT); }
__device__ __forceinline__ unsigned xb_add(unsigned* p, unsigned v) { return __hip_atomic_fetch_add(p, v, __ATOMIC_RELAXED, __HIP_MEMORY_SCOPE_AGENT); }
__device__ __forceinline__ unsigned xb_xcc_id() { return (unsigned)__builtin_amdgcn_s_getreg((3 << 11) | 20) & 0xFu; }
#define XB_SPIN(cond, bar) do { unsigned _sp = 0; while (cond) { __builtin_amdgcn_s_sleep(1); \
    if ((++_sp & 255u) == 0u) { if (xb_ld(&(bar)[XB_TMO])) break; if (_sp > XB_SPIN_CAP) { atomicAdd(&(bar)[XB_TMO], 1u); break; } } } } while (0)
struct XcdBarrier { unsigned* bar; unsigned x; volatile LAS unsigned* st; };
__device__ __forceinline__ XcdBarrier xcd_barrier_post(unsigned* bar, volatile LAS unsigned* st) {
    XcdBarrier b; b.bar = bar; b.x = xb_xcc_id(); b.st = st;
    if (threadIdx.x == 0) (void)xb_add(&bar[XB_XCNT(b.x)], 1u);
    return b;
}
__device__ __forceinline__ void xcd_barrier_complete(unsigned* bar, unsigned x, unsigned& nloc, unsigned& nx) {
    const unsigned G = gridDim.x * gridDim.y * gridDim.z;
    unsigned sum, cnt, mine, sp = 0u;
    for (;;) {
        sum = 0u; cnt = 0u; mine = 0u;
#pragma unroll
        for (unsigned j = 0; j < 16; ++j) { const unsigned c = xb_ld(&bar[XB_XCNT(j)]); sum += c; cnt += (c > 0u) ? 1u : 0u; mine = (j == x) ? c : mine; }
        if (sum == G) break;
        __builtin_amdgcn_s_sleep(1);
        if ((++sp & 255u) == 0u) { if (xb_ld(&bar[XB_TMO])) break; if (sp > XB_SPIN_CAP) { atomicAdd(&bar[XB_TMO], 1u); break; } }
    }
    nloc = mine > 0u ? mine : 1u; nx = cnt > 0u ? cnt : 1u;
}
__device__ __forceinline__ void xcd_barrier(const XcdBarrier& b) {
    asm volatile("s_waitcnt vmcnt(0)" ::: "memory");
    __syncthreads();
    if (threadIdx.x == 0) {
        unsigned* bar = b.bar;
        __builtin_amdgcn_s_waitcnt(0);
        unsigned nloc = b.st[0], nx = b.st[1];
        if (nloc == 0u) { xcd_barrier_complete(bar, b.x, nloc, nx); b.st[0] = nloc; b.st[1] = nx; }
        const unsigned old = xb_add(&bar[XB_XSUB(b.x)], 1u);
        const unsigned gen = old / nloc;
        if (old + 1u == (gen + 1u) * nloc) {
            __builtin_amdgcn_fence(__ATOMIC_RELEASE, "agent");
            asm volatile("s_waitcnt vmcnt(0)" ::: "memory");
            const unsigned og = xb_add(&bar[XB_TOP], 1u);
            const unsigned tg = og / nx;
            if (og + 1u == (tg + 1u) * nx) xb_add(&bar[XB_TOPGEN], 1u);
            else XB_SPIN(xb_ld(&bar[XB_TOPGEN]) == tg, bar);
            __builtin_amdgcn_fence(__ATOMIC_ACQUIRE, "agent");
            xb_add(&bar[XB_XGEN(b.x)], 1u);
            asm volatile("s_waitcnt vmcnt(0)" ::: "memory");
        } else {
            XB_SPIN(xb_ld(&bar[XB_XGEN(b.x)]) == gen, bar);
            __builtin_amdgcn_fence(__ATOMIC_ACQUIRE, "agent");
            asm volatile("s_waitcnt vmcnt(0)" ::: "memory");
        }
    }
    __syncthreads();
}

__global__ void __launch_bounds__(512, 2) fwd_kernel(Params p) {
    extern __shared__ __attribute__((aligned(16))) unsigned char lds_raw[];
    LAS unsigned char* lds = (LAS unsigned char*)lds_raw;
    cg::grid_group grid = cg::this_grid();
    const int tid = threadIdx.x, lane = tid & 63, wave = __builtin_amdgcn_readfirstlane(tid >> 6);
    const int G = gridDim.x, bx = blockIdx.x;
    const int vcu = (G % 8 == 0) ? (bx % 8) * (G / 8) + bx / 8 : bx;
    const int gw = vcu * 8 + wave, NGW = G * 8;
    unsigned char* ws = p.ws;
    const int lo = p.ph_lo, hi = p.ph_hi;
    volatile LAS unsigned* xbst = (volatile LAS unsigned*)(lds + 131072);
    if (tid < 2) xbst[tid] = 0u;
    __syncthreads();
    XcdBarrier xbar = xcd_barrier_post((unsigned*)ws, xbst);
#ifndef PHMASK
#define PHMASK 0xFFFF
#endif
#define IN(k) (((PHMASK >> (k)) & 1) && lo <= (k) && (k) < hi)
#ifndef REP_PHASE
#define REP_PHASE -1
#endif
#define REPS(k) for (int rep_ = 0; rep_ < ((k) == REP_PHASE ? 2 : 1); ++rep_)
#define SEAM(k) do { if (IN(k) && IN((k) + 1)) { if ((k) == 0) { asm volatile("s_waitcnt vmcnt(0) lgkmcnt(0)" ::: "memory"); __syncthreads(); grid.sync(); } else xcd_barrier(xbar); } } while (0)
    float* XR = p.out;
    bf16_t* XB = (bf16_t*)(ws + WS_XB); bf16_t* ACT = (bf16_t*)(ws + WS_PR); bf16_t* X2B = XB; bf16_t* MIXB = (bf16_t*)(ws + WS_S5);
    float* SLAB = (float*)(ws + WS_SLAB);
    float* ss1 = (float*)(ws + WS_SS1); float* ss2 = (float*)(ws + WS_SS2); float* ss3 = (float*)(ws + WS_SS3); float* ss4 = (float*)(ws + WS_SS4);

    if (IN(0)) REPS(0) phase0(p, lds, gw, NGW, wave, lane);
    SEAM(0);
    if (IN(1)) REPS(1) { pg8::Gemm g{XB, (const bf16_t*)(ws + WS_WGU1), M, 2 * FF, D}; pg8::StaticOrder S; S.init(M, 2 * FF, D, G, bx, 0);
        EpiGU E{ACT, ss1}; pg8::gemm_phase<EpiGU>(lds, g, S, E); }
    SEAM(1);
    if (IN(2)) { pg8::Gemm g{ACT, (const bf16_t*)(ws + WS_WD1), M, D, FF}; pg8::StaticOrder S; S.init(MP, D, FF, G, bx, 11);
        EpiRes E{p.in[0], p.in[1], XR, XB, ss2, 0.5f, SLAB, 4}; pg8::gemm_phase<EpiRes, true>(lds, g, S, E);
        xcd_barrier(xbar); fix_sample_rows(XR, SLAB, 11, 0.5f, ss2, XB, gw, NGW, lane); }
    SEAM(2);
    if (IN(3)) { pg8::Gemm g{XB, (const bf16_t*)(ws + WS_WIN), M, NIN, D}; pg8::StaticOrder S; S.init(M, NIN, D, G, bx, 0);
        EpiIn E{(bf16_t*)(ws + WS_PR), (bf16_t*)(ws + WS_PA), ss2, p.out}; pg8::gemm_phase<EpiIn>(lds, g, S, E); }
    SEAM(3);
    if (IN(4)) {
        prep_load_params(lds, p, tid);
        REPS(4) { for (int ug = vcu; ug < MP / 128; ug += G) prep_unit(lds, p, ug * 8 + wave, lane, tid, 0, 8);
            for (int st = vcu; st < 16; st += G) prep_unit(lds, p, (MP / 128 + (st >> 3)) * 8 + wave, lane, tid, st & 7, (st & 7) + 1); }
        __syncthreads();
        LAS unsigned char* wl = lds + wave * ATT_WL;
        {
            const int hh = gw & 7; LAS float* tab = (LAS float*)(wl + 9216); float tv[5];
#pragma unroll
            for (int i = 0; i < 5; ++i) { const int idx = lane + 64 * i; tv[i] = p.in[23][hh * 257 + (idx < 257 ? idx : 256)]; }
#pragma unroll
            for (int i = 0; i < 5; ++i) { const int idx = lane + 64 * i; if (idx < 257) tab[idx] = tv[i] * 1.44269504089f; }
        }
        for (int u = gw; u < 8 * 128 * 8 * 2; u += NGW) attn_prompt_unit(wl, (bf16_t*)(ws + WS_PA), p.in[23], u, lane);
        for (int u = gw; u < 16 * 8 * 16; u += NGW) attn_sample_unit(wl, p, u, lane);
    }
    SEAM(4);
    if (IN(5)) REPS(5) {
        for (int u = vcu; u < 256; u += G) { const int bh = u >> 2, vq = u & 3, b = bh >> 3, h = bh & 7;
            scan_unit<32>(lds, p, (size_t)b * SEQ, SEQ, h, vq, nullptr, p.out + O_PWKV + (size_t)bh * 4096, tid); }
        for (int u = vcu; u < 512; u += G) { const int bh = u >> 2, vq = u & 3, sb = bh >> 3, h = bh & 7;
            scan_unit<16>(lds, p, (size_t)MP + sb * 16, 16, h, vq, p.in[3] + (size_t)bh * 4096, p.out + O_SWKV + (size_t)bh * 4096, tid); }
    }
    SEAM(5);
    if (IN(6)) REPS(6) { for (int m = gw; m < M; m += NGW) post_row(p, m, lane); }
    SEAM(6);
    if (IN(7)) { pg8::Gemm g{MIXB, (const bf16_t*)(ws + WS_WOUT), M, D, D}; pg8::StaticOrder S; S.init(MP, D, D, G, bx, 4);
        EpiRes E{XR, XR + (size_t)MP * D, XR, X2B, ss3, 1.0f, SLAB, 4}; pg8::gemm_phase<EpiRes, true>(lds, g, S, E);
        xcd_barrier(xbar); fix_sample_rows(XR, SLAB, 4, 1.0f, ss3, X2B, gw, NGW, lane); }
    SEAM(7);
    if (IN(8)) { pg8::Gemm g{X2B, (const bf16_t*)(ws + WS_WGU2), M, 2 * FF, D}; pg8::StaticOrder S; S.init(M, 2 * FF, D, G, bx, 0);
        EpiGU E{ACT, ss3}; pg8::gemm_phase<EpiGU>(lds, g, S, E); }
    SEAM(8);
    if (IN(9)) { pg8::Gemm g{ACT, (const bf16_t*)(ws + WS_WD2), M, D, FF}; pg8::StaticOrder S; S.init(MP, D, FF, G, bx, 11);
        EpiRes E{XR, XR + (size_t)MP * D, XR, nullptr, nullptr, 0.5f, SLAB, 4}; pg8::gemm_phase<EpiRes, true>(lds, g, S, E);
        xcd_barrier(xbar); fix_sample_rows(XR, SLAB, 11, 0.5f, nullptr, nullptr, gw, NGW, lane); }
    SEAM(9);
    if (IN(10)) {
        const float* nf = p.in[29];
        for (int m = gw; m < M; m += NGW) {
            f32x4* xr = (f32x4*)(XR + (size_t)m * D) + lane;
            f32x4 v[4]; float sq = 0.f;
#pragma unroll
            for (int j = 0; j < 4; ++j) { v[j] = xr[64 * j]; sq += v[j].x * v[j].x + v[j].y * v[j].y + v[j].z * v[j].z + v[j].w * v[j].w; }
            const float rs = rsqrtf(wave_sum(sq) * (1.f / 1024.f) + NORM_EPS);
#pragma unroll
            for (int j = 0; j < 4; ++j) { const f32x4 g4 = *((const f32x4*)nf + 64 * j + lane); xr[64 * j] = v[j] * rs * g4; }
        }
    }
#ifdef DUMP
    if (lo == 13) {
        const bf16_t* MIXd = (const bf16_t*)(ws + WS_S5);
        const float* Yd = (const float*)(ws + WS_PR); const bf16_t* SGd = (const bf16_t*)(ws + WS_G); const bf16_t* SRd = (const bf16_t*)(ws + WS_S5);
        const bf16_t* PAd = (const bf16_t*)(ws + WS_PA);
        for (int m = gw; m < M; m += NGW)
            for (int c = lane; c < D; c += 64) { float v = 0.f;
                if (DUMP == 2 && c < 512) v = bf2f(MIXd[(size_t)m * D + c]);
                if (DUMP == 3 && c >= 512) v = bf2f(MIXd[(size_t)m * D + c]);
                if (DUMP == 4 && c < 512) v = Yd[(size_t)m * RW + c];
                if (DUMP == 5 && c < 512) v = bf2f(SGd[(size_t)m * RW + c]);
                if (DUMP == 6 && c < 512) v = bf2f(SRd[(size_t)m * RW + c]);
                if (DUMP == 7 && c < 512) v = bf2f(PAd[(size_t)m * AC + c]);
                if (DUMP == 8 && c < 128) v = bf2f(((const bf16_t*)(ws + WS_PR))[(size_t)m * RC + 1664 + c]);
                if (DUMP == 9 && c < 128) v = bf2f(((const bf16_t*)(ws + WS_GL))[(size_t)(m & 511) * 128 + c]);
                XR[(size_t)m * D + c] = v; }
    }
#endif
#undef IN
#undef SEAM
}

extern "C" void kernel_launch(void* const* d_in, const int* in_sizes, int n_in, void* d_out, int out_size, void* d_ws, size_t ws_size, hipStream_t stream) {
    static int grid = 0;
    if (grid == 0) {
        if (n_in != 30 || ws_size < WS_END) { fprintf(stderr, "kernel_launch: unexpected n_in %d or ws_size %zu (< %zu)\n", n_in, ws_size, (size_t)WS_END); grid = -1; return; }
        int dev = 0, cus = 0, per_cu = 0;
        (void)hipGetDevice(&dev); (void)hipDeviceGetAttribute(&cus, hipDeviceAttributeMultiprocessorCount, dev);
        if (hipFuncSetAttribute((const void*)fwd_kernel, hipFuncAttributeMaxDynamicSharedMemorySize, LDS_BYTES) != hipSuccess) { fprintf(stderr, "kernel_launch: hipFuncSetAttribute failed\n"); grid = -1; return; }
        if (hipOccupancyMaxActiveBlocksPerMultiprocessor(&per_cu, (const void*)fwd_kernel, 512, LDS_BYTES) != hipSuccess || per_cu < 1) { fprintf(stderr, "kernel_launch: occupancy query failed (%d)\n", per_cu); (void)hipGetLastError(); per_cu = 1; }
        grid = cus * per_cu;
    }
    if (grid < 0) return;
    Params p{};
    for (int i = 0; i < 30; ++i) p.in[i] = (const float*)d_in[i];
    p.out = (float*)d_out; p.ws = (unsigned char*)d_ws;
    (void)hipMemsetAsync(d_ws, 0, XCD_BAR_WORDS * 4, stream);
#ifndef MULTI_LAUNCH
#define MULTI_LAUNCH 0
#endif
#ifndef NPH
#define NPH 11

#endif
#if MULTI_LAUNCH
    for (int k = 0; k < NPH; ++k) { p.ph_lo = k; p.ph_hi = k + 1; hipLaunchKernelGGL(fwd_kernel, dim3(grid), dim3(512), LDS_BYTES, stream, p); }
#ifdef DUMP
    p.ph_lo = 13; p.ph_hi = 14; hipLaunchKernelGGL(fwd_kernel, dim3(grid), dim3(512), LDS_BYTES, stream, p);
#endif
#else
    p.ph_lo = 0; p.ph_hi = 11;
    void* args[] = {&p};
    hipError_t e = hipLaunchCooperativeKernel((const void*)fwd_kernel, dim3(grid), dim3(512), args, LDS_BYTES, stream);
    if (e != hipSuccess) fprintf(stderr, "kernel_launch: cooperative launch failed: %s (grid %d)\n", hipGetErrorString(e), grid);
#endif
}
```

```cpp
#include <hip/hip_runtime.h>


#include <hip/hip_cooperative_groups.h>
#include <cstdio>
namespace cg = cooperative_groups;

#define LAS __attribute__((address_space(3)))
typedef unsigned short bf16_t;
typedef short bf16x8 __attribute__((ext_vector_type(8)));
typedef float f32x4 __attribute__((ext_vector_type(4)));
typedef float f32x2 __attribute__((ext_vector_type(2)));
typedef unsigned u32x4 __attribute__((ext_vector_type(4)));
typedef unsigned u32x2 __attribute__((ext_vector_type(2)));

constexpr int MP = 65536, MS = 256, M = MP + MS, D = 1024, FF = 2816, NIN = 3328, RC = 1792, AC = 1536, RW = 512;
constexpr int SEQ = 8192;
constexpr float NORM_EPS = 1e-5f, GN_EPS = 64e-5f;
constexpr size_t O_YP = 0, O_YS = 67108864, O_PSH = 67371008, O_PWKV = 67385344, O_PK = 67647488, O_PV = 69744640,
                 O_SSH = 71841792, O_SWKV = 71870464, O_SK = 72394752, O_SV = 72525824;
constexpr size_t SSB = (size_t)M * 4;
constexpr size_t WS_SS1 = 65536, WS_SS2 = WS_SS1 + SSB, WS_SS3 = WS_SS2 + SSB, WS_SS4 = WS_SS3 + SSB;
constexpr size_t WS_BON = 2097152;
constexpr size_t WS_W = 5242880;
constexpr size_t WS_WGU1 = WS_W, WS_WD1 = WS_WGU1 + (size_t)2 * FF * D * 2, WS_WIN = WS_WD1 + (size_t)D * FF * 2, WS_WOUT = WS_WIN + (size_t)NIN * D * 2,
                 WS_WGU2 = WS_WOUT + (size_t)D * D * 2, WS_WD2 = WS_WGU2 + (size_t)2 * FF * D * 2, WS_WL = WS_WD2 + (size_t)D * FF * 2,
                 WS_AL = WS_WL + 512 * 64 * 2, WS_GL = WS_AL + 512 * 64 * 2, WS_WEND = WS_GL + 512 * 128 * 2;
constexpr size_t WS_XB = WS_WEND;
constexpr size_t WS_PR = WS_XB + (size_t)M * D * 2;
constexpr size_t WS_PA = WS_PR + (size_t)M * RC * 2;
constexpr size_t WS_S5 = WS_PA + (size_t)M * AC * 2;
constexpr size_t S5B = (size_t)M * RW * 2;
constexpr size_t WS_G = WS_S5 + 5 * S5B;
constexpr size_t WS_INV = WS_G + S5B;
constexpr size_t WS_SLAB = WS_INV + (size_t)M * 8 * 4;
constexpr size_t WS_END = WS_SLAB + (size_t)11 * MS * D * 4;
constexpr int LDS_BYTES = 131072 + 2048;

typedef __bf16 bf16x2_t __attribute__((ext_vector_type(2)));
__device__ __forceinline__ unsigned cvt_pk_bf16(float lo, float hi) { const f32x2 v = {lo, hi}; return __builtin_bit_cast(unsigned, __builtin_convertvector(v, bf16x2_t)); }
__device__ __forceinline__ float bf2f(unsigned short u) { return __builtin_bit_cast(float, (unsigned)u << 16); }
__device__ __forceinline__ float bflo(unsigned u) { return __builtin_bit_cast(float, u << 16); }
__device__ __forceinline__ float bfhi(unsigned u) { return __builtin_bit_cast(float, u & 0xffff0000u); }
__device__ __forceinline__ unsigned short f2bf(float f) { return __builtin_bit_cast(unsigned short, (__bf16)f); }
__device__ __forceinline__ float wave_sum(float v) {
#pragma unroll
    for (int o = 1; o < 64; o <<= 1) v += __shfl_xor(v, o);
    return v;
}
__device__ __forceinline__ float wave_max(float v) {
#pragma unroll
    for (int o = 1; o < 64; o <<= 1) v = fmaxf(v, __shfl_xor(v, o));
    return v;
}
template <int CTRL> __device__ __forceinline__ float dppf(float v) { return __builtin_bit_cast(float, __builtin_amdgcn_mov_dpp(__builtin_bit_cast(int, v), CTRL, 0xF, 0xF, true)); }
__device__ __forceinline__ float row16_sum(float v) { v += dppf<0xB1>(v); v += dppf<0x4E>(v); v += dppf<0x141>(v); v += dppf<0x140>(v); return v; }
__device__ __forceinline__ float row8_sum(float v) { v += dppf<0xB1>(v); v += dppf<0x4E>(v); v += dppf<0x141>(v); return v; }
__device__ __forceinline__ float fast_exp(float x) { return __builtin_amdgcn_exp2f(x * 1.44269504089f); }
__device__ __forceinline__ float sigmoidf_(float x) { return __builtin_amdgcn_rcpf(1.f + fast_exp(-x)); }

__device__ __forceinline__ float xsum_quads(float v) {
    unsigned u = __builtin_bit_cast(unsigned, v);
    auto r = __builtin_amdgcn_permlane16_swap(u, u, false, false);
    v = __builtin_bit_cast(float, (unsigned)r[0]) + __builtin_bit_cast(float, (unsigned)r[1]);
    u = __builtin_bit_cast(unsigned, v);
    auto q = __builtin_amdgcn_permlane32_swap(u, u, false, false);
    return __builtin_bit_cast(float, (unsigned)q[0]) + __builtin_bit_cast(float, (unsigned)q[1]);
}

namespace pg8 {
constexpr int BM = 256, BK = 64, HALF = 128, HTB = HALF * BK * 2, STAGE_BYTES = 8 * HTB, NXCD = 8, WGM = 8;
__host__ __device__ __forceinline__ int lds_byte(int r, int c) { const int st = (r >> 4) * 2 + (c >> 5), rr = r & 15, cc = c & 31, ob = rr * 64 + cc * 2; return st * 1024 + (ob ^ (((ob >> 9) & 1) << 5)); }
__host__ __device__ __forceinline__ void stage_rc(int b, int& R, int& C) { const int st = b / 1024, sb = b % 1024, swz = sb ^ (((sb >> 9) & 1) << 5); R = (st >> 1) * 16 + swz / 64; C = (st & 1) * 32 + (swz % 64) / 2; }
__host__ __device__ __forceinline__ int perm32(int rho) { const int n = rho >> 4, i = rho & 15; return 8 * (i >> 2) + 4 * n + (i & 3); }
struct Unit { int pm, pk;
    __device__ __forceinline__ int pn() const { return pk & 0xff; } __device__ __forceinline__ int kt0() const { return (pk >> 8) & 0xff; }
    __device__ __forceinline__ int nt() const { return (pk >> 16) & 0xff; } __device__ __forceinline__ int slice() const { return pk >> 24; } };
struct Gemm { const bf16_t* A; const bf16_t* Bt; int M, N, K; };
struct StaticOrder {
    int nM, nN, nwg, G, c, ntf, nsl, nts;
    __device__ __forceinline__ void init(int M_, int N_, int K_, int G_, int c_, int nsl_) { nM = M_ / BM; nN = N_ / BM; nwg = nM * nN; G = G_; c = c_; ntf = K_ / BK; nsl = nsl_; nts = nsl_ ? ntf / nsl_ : 0; }
    __device__ __forceinline__ bool next(int i, Unit& u) const {
        const long L = (long)i * G + c;
        if (L >= nwg) {
            const long sidx = L - nwg; if (sidx >= (long)nN * nsl) return false;
            u.pm = nM; u.pk = (int)(sidx % nN) | (((int)(sidx / nN) * nts) << 8) | (nts << 16) | (1 << 24); return true;
        }
        int wgid = (int)L; { const int q = nwg / NXCD, r = nwg % NXCD, xcd = wgid % NXCD, off = wgid / NXCD; wgid = (xcd < r ? xcd * (q + 1) : r * (q + 1) + (xcd - r) * q) + off; }
        const int nig = WGM * nN, gid = wgid / nig, fm = gid * WGM, gsz = (nM - fm) < WGM ? (nM - fm) : WGM;
        u.pm = fm + ((wgid % nig) % gsz); u.pk = ((wgid % nig) / gsz) | (ntf << 16); return true;
    }
};

template <class Epi, bool SLICED = false>
__device__ __forceinline__ void gemm_phase(LAS unsigned char* lds, const Gemm g, const StaticOrder& S, const Epi& E) {
    const int tid = threadIdx.x, wid = __builtin_amdgcn_readfirstlane(tid >> 6), lane = tid & 63, wr = wid >> 2, wc = wid & 3, fr = lane & 15, fq = lane >> 4;
    const int K = g.K;
    unsigned voffA[2], voffB[2];
#pragma unroll
    for (int i = 0; i < 2; ++i) { int R, C; stage_rc(tid * 16 + i * 8192, R, C); const int Rb = Epi::PERM ? ((R & ~31) + perm32(R & 31)) : R;
        voffA[i] = (unsigned)(R * K + C) * 2u; voffB[i] = (unsigned)(Rb * K + C) * 2u; }
    const size_t kstep = (size_t)(BK * 2);
    const size_t hstep = (size_t)HALF * K * 2;
    const size_t tstep = 2 * hstep;
    const unsigned ldsw = (unsigned)wid * 1024u;
    const int aoff = lds_byte(wr * 64 + fr, fq * 8), boff = lds_byte(wc * 32 + fr, fq * 8);
#define PG8_SA(b, h) (((b) * 2 + (h)) * HTB)
#define PG8_SB(b, h) ((4 + (b) * 2 + (h)) * HTB)
#define PG8_STAGE(bufoff, gbase, voff) do { _Pragma("unroll") for (int _i = 0; _i < 2; ++_i) \
        __builtin_amdgcn_global_load_lds((const unsigned*)((const char*)(gbase) + (voff)[_i]), (LAS unsigned*)(lds + (bufoff) + ldsw + _i * 8192), 16, 0, 0); } while (0)
#define PG8_LDA(dst, b, h) do { _Pragma("unroll") for (int m = 0; m < 4; ++m) _Pragma("unroll") for (int k = 0; k < 2; ++k) dst[m][k] = *(const LAS bf16x8*)(lds + PG8_SA(b, h) + aoff + m * 2048 + k * 1024); } while (0)
#define PG8_LDB(dst, b, h) do { _Pragma("unroll") for (int n = 0; n < 2; ++n) _Pragma("unroll") for (int k = 0; k < 2; ++k) dst[n][k] = *(const LAS bf16x8*)(lds + PG8_SB(b, h) + boff + n * 2048 + k * 1024); } while (0)
#define PG8_MMA(ai, bj, At, Bt) do { __builtin_amdgcn_s_setprio(1); _Pragma("unroll") for (int m = 0; m < 4; ++m) _Pragma("unroll") for (int n = 0; n < 2; ++n) _Pragma("unroll") for (int k = 0; k < 2; ++k) \
        acc[ai][bj][m][n] = __builtin_amdgcn_mfma_f32_16x16x32_bf16(Bt[n][k], At[m][k], acc[ai][bj][m][n], 0, 0, 0); __builtin_amdgcn_s_setprio(0); } while (0)
#define PG8_WAIT_V(n) asm volatile("s_waitcnt vmcnt(" #n ")" ::: "memory")
#define PG8_WAIT_L(n) asm volatile("s_waitcnt lgkmcnt(" #n ")" ::: "memory")
#define PG8_BAR __builtin_amdgcn_s_barrier()
#define PG8_SCHED __builtin_amdgcn_sched_barrier(0)
    Unit cur, nxt; int ui = 0;
    if (!S.next(0, cur)) return;
    f32x4 acc[2][2][4][2];
#pragma unroll
    for (int a = 0; a < 2; ++a)
#pragma unroll
        for (int b = 0; b < 2; ++b)
#pragma unroll
            for (int m = 0; m < 4; ++m)
#pragma unroll
                for (int n = 0; n < 2; ++n) acc[a][b][m][n] = (f32x4){0.f, 0.f, 0.f, 0.f};
    bf16x8 At[4][2], B0[2][2], B1[2][2];
    typename Epi::Pre pre = E.prefetch(cur, wr, fr);
    const char* cA = (const char*)g.A + (size_t)cur.pm * tstep + (SLICED ? (size_t)cur.kt0() * kstep : 0); const char* cB = (const char*)g.Bt + (size_t)cur.pn() * tstep + (SLICED ? (size_t)cur.kt0() * kstep : 0);
    PG8_STAGE(PG8_SB(0, 0), cB, voffB); PG8_STAGE(PG8_SA(0, 0), cA, voffA); PG8_STAGE(PG8_SB(0, 1), cB + hstep, voffB); PG8_STAGE(PG8_SA(0, 1), cA + hstep, voffA);
    if (wr == 1) PG8_BAR;
    PG8_WAIT_V(4); PG8_BAR;
    PG8_STAGE(PG8_SB(1, 0), cB + kstep, voffB); PG8_STAGE(PG8_SA(1, 0), cA + kstep, voffA); PG8_STAGE(PG8_SB(1, 1), cB + hstep + kstep, voffB);
    PG8_WAIT_V(6); PG8_BAR;
    for (;;) {
        const bool has_next = S.next(ui + 1, nxt);
        const char* nA = has_next ? (const char*)g.A + (size_t)nxt.pm * tstep + (SLICED ? (size_t)nxt.kt0() * kstep : 0) : cA; const char* nB = has_next ? (const char*)g.Bt + (size_t)nxt.pn() * tstep + (SLICED ? (size_t)nxt.kt0() * kstep : 0) : cB;
        const int nt = SLICED ? cur.nt() : K / BK;
        for (int t = 0; t < nt; t += 2) {
            const bool last = (t == nt - 2);
            const char* a1 = cA + (size_t)(t + 1) * kstep;
            const char* a2 = last ? nA : cA + (size_t)(t + 2) * kstep; const char* b2 = last ? nB : cB + (size_t)(t + 2) * kstep;
            const char* a3 = a2 + kstep; const char* b3 = b2 + kstep;
            PG8_LDB(B0, 0, 0); PG8_SCHED; PG8_LDA(At, 0, 0); PG8_STAGE(PG8_SA(1, 1), a1 + hstep, voffA);
            PG8_WAIT_L(8); PG8_BAR; PG8_WAIT_L(0); PG8_MMA(0, 0, At, B0); PG8_BAR; PG8_SCHED;
            PG8_LDB(B1, 0, 1); PG8_STAGE(PG8_SB(0, 0), b2, voffB);
            PG8_BAR; PG8_WAIT_L(0); PG8_MMA(0, 1, At, B1); PG8_BAR;
            PG8_LDA(At, 0, 1); PG8_STAGE(PG8_SA(0, 0), a2, voffA);
            PG8_BAR; PG8_WAIT_L(0); PG8_MMA(1, 0, At, B0); PG8_BAR; PG8_SCHED;
            PG8_STAGE(PG8_SB(0, 1), b2 + hstep, voffB);
            PG8_WAIT_V(6); PG8_BAR; PG8_MMA(1, 1, At, B1); PG8_BAR;
            PG8_LDB(B0, 1, 0); PG8_SCHED; PG8_LDA(At, 1, 0); PG8_STAGE(PG8_SA(0, 1), a2 + hstep, voffA);
            PG8_WAIT_L(8); PG8_BAR; PG8_WAIT_L(0); PG8_MMA(0, 0, At, B0); PG8_BAR; PG8_SCHED;
            PG8_LDB(B1, 1, 1); PG8_STAGE(PG8_SB(1, 0), b3, voffB);
            PG8_BAR; PG8_WAIT_L(0); PG8_MMA(0, 1, At, B1); PG8_BAR;
            PG8_LDA(At, 1, 1); PG8_STAGE(PG8_SA(1, 0), a3, voffA);
            PG8_BAR; PG8_WAIT_L(0); PG8_MMA(1, 0, At, B0); PG8_BAR; PG8_SCHED;
            PG8_STAGE(PG8_SB(1, 1), b3 + hstep, voffB);
            PG8_WAIT_V(6); PG8_BAR; PG8_MMA(1, 1, At, B1); PG8_BAR;
        }
        E(acc, cur, wr, wc, fr, fq, pre);
        if (!has_next) break;
        pre = E.prefetch(nxt, wr, fr);
#pragma unroll
        for (int a = 0; a < 2; ++a)
#pragma unroll
            for (int b = 0; b < 2; ++b)
#pragma unroll
                for (int m = 0; m < 4; ++m)
#pragma unroll
                    for (int n = 0; n < 2; ++n) acc[a][b][m][n] = (f32x4){0.f, 0.f, 0.f, 0.f};
        cur = nxt; cA = nA; cB = nB; ++ui;
    }
    PG8_WAIT_V(0);
    if (wr == 0) PG8_BAR;
    PG8_BAR;
#undef PG8_SA
#undef PG8_SB
#undef PG8_STAGE
#undef PG8_LDA
#undef PG8_LDB
#undef PG8_MMA
#undef PG8_WAIT_V
#undef PG8_WAIT_L
#undef PG8_BAR
#undef PG8_SCHED
}
}

struct EpiGU {
    static constexpr bool PERM = true;
    bf16_t* O; const float* ss;
    struct Pre { float s[8]; };
    __device__ __forceinline__ Pre prefetch(const pg8::Unit& u, int wr, int fr) const { Pre q; const int row0 = u.pm * 256 + wr * 64 + fr;
#pragma unroll
        for (int i = 0; i < 8; ++i) q.s[i] = ss[row0 + (i >> 2) * 128 + (i & 3) * 16];
        return q; }
    __device__ __forceinline__ void operator()(const f32x4 (&acc)[2][2][4][2], const pg8::Unit& u, int wr, int wc, int fr, int fq, const Pre& pre) const {
        const int row0 = u.pm * 256 + wr * 64 + fr, col0 = u.pn() * 128 + wc * 32 + 8 * fq;
#pragma unroll
        for (int ai = 0; ai < 2; ++ai)
#pragma unroll
            for (int m = 0; m < 4; ++m) {
                const int row = row0 + ai * 128 + m * 16;
                const float rs = rsqrtf(pre.s[ai * 4 + m] * (1.f / 1024.f) + NORM_EPS);
                f32x4 ov[2];
#pragma unroll
                for (int n = 0; n < 2; ++n) {
                    const f32x4 g4 = acc[ai][0][m][n] * rs, u4 = acc[ai][1][m][n] * rs;
                    const f32x4 t4 = g4 * (-1.44269504089f);
                    f32x4 e4; e4.x = __builtin_amdgcn_exp2f(t4.x); e4.y = __builtin_amdgcn_exp2f(t4.y); e4.z = __builtin_amdgcn_exp2f(t4.z); e4.w = __builtin_amdgcn_exp2f(t4.w);
                    const f32x4 d4 = e4 + 1.0f;
                    f32x4 r4; r4.x = __builtin_amdgcn_rcpf(d4.x); r4.y = __builtin_amdgcn_rcpf(d4.y); r4.z = __builtin_amdgcn_rcpf(d4.z); r4.w = __builtin_amdgcn_rcpf(d4.w);
                    ov[n] = (g4 * u4) * r4;
                }
                u32x4 w; w.x = cvt_pk_bf16(ov[0].x, ov[0].y); w.y = cvt_pk_bf16(ov[0].z, ov[0].w); w.z = cvt_pk_bf16(ov[1].x, ov[1].y); w.w = cvt_pk_bf16(ov[1].z, ov[1].w);
                *(u32x4*)(O + (size_t)row * FF + col0) = w;
            }
    }
};
struct EpiRes {
    static constexpr bool PERM = true;
    const float* resP; const float* resS; float* XR; bf16_t* XBo; float* ssn; float scale; float* slab; int nts;
    struct Pre {};
    __device__ __forceinline__ Pre prefetch(const pg8::Unit&, int, int) const { return Pre{}; }
    __device__ __forceinline__ void operator()(const f32x4 (&acc)[2][2][4][2], const pg8::Unit& u, int wr, int wc, int fr, int fq, const Pre&) const {
        const int row0 = u.pm * 256 + wr * 64 + fr, col0 = u.pn() * 256 + wc * 32 + 8 * fq;
        if (u.slice()) {
            float* sl = slab + (size_t)(u.kt0() / nts) * (MS * D) + (size_t)(row0 - MP) * D + col0;
#pragma unroll
            for (int ai = 0; ai < 2; ++ai)
#pragma unroll
                for (int m = 0; m < 4; ++m)
#pragma unroll
                    for (int bj = 0; bj < 2; ++bj) { float* q = sl + (size_t)(ai * 128 + m * 16) * D + bj * 128;
                        *(f32x4*)q = acc[ai][bj][m][0]; *(f32x4*)(q + 4) = acc[ai][bj][m][1]; }
            return;
        }
        f32x4 q0[2], q1[2];
#pragma unroll
        for (int it = 0; it < 2; ++it) { const int row = row0 + (it >> 3) * 128 + ((it >> 1) & 3) * 16;
            const float* rp = (row < MP ? resP + (size_t)row * D : resS + (size_t)(row - MP) * D) + col0 + (it & 1) * 128;
            q0[it] = *(const f32x4*)rp; q1[it] = *(const f32x4*)(rp + 4); }
        float sq = 0.f;
#pragma unroll
        for (int it = 0; it < 16; ++it) {
            const int ai = it >> 3, m = (it >> 1) & 3, bj = it & 1;
            const int row = row0 + ai * 128 + m * 16, c = col0 + bj * 128;
            const f32x4 r0 = q0[it & 1], r1 = q1[it & 1];
            if (it + 2 < 16) { const int it2 = it + 2; const int row2 = row0 + (it2 >> 3) * 128 + ((it2 >> 1) & 3) * 16;
                const float* rp = (row2 < MP ? resP + (size_t)row2 * D : resS + (size_t)(row2 - MP) * D) + col0 + (it2 & 1) * 128;
                q0[it & 1] = *(const f32x4*)rp; q1[it & 1] = *(const f32x4*)(rp + 4); }
            const f32x4 v0 = r0 + scale * acc[ai][bj][m][0], v1 = r1 + scale * acc[ai][bj][m][1];
            *(f32x4*)(XR + (size_t)row * D + c) = v0; *(f32x4*)(XR + (size_t)row * D + c + 4) = v1;
            sq += v0.x * v0.x + v0.y * v0.y + v0.z * v0.z + v0.w * v0.w + v1.x * v1.x + v1.y * v1.y + v1.z * v1.z + v1.w * v1.w;
            if (XBo) { u32x4 w; w.x = cvt_pk_bf16(v0.x, v0.y); w.y = cvt_pk_bf16(v0.z, v0.w); w.z = cvt_pk_bf16(v1.x, v1.y); w.w = cvt_pk_bf16(v1.z, v1.w);
                *(u32x4*)(XBo + (size_t)row * D + c) = w; }
            if (bj == 1) { if (ssn) { const float tot = xsum_quads(sq); if (fq == 0) atomicAdd(ssn + row, tot); } sq = 0.f; }
        }
    }
};
struct EpiIn {
    static constexpr bool PERM = true;
    bf16_t* PR; bf16_t* PA; const float* ss; float* out;
    struct Pre { float s[8]; };
    __device__ __forceinline__ Pre prefetch(const pg8::Unit& u, int wr, int fr) const { Pre q; const int row0 = u.pm * 256 + wr * 64 + fr;
#pragma unroll
        for (int i = 0; i < 8; ++i) q.s[i] = ss[row0 + (i >> 2) * 128 + (i & 3) * 16];
        return q; }
    __device__ __forceinline__ void operator()(const f32x4 (&acc)[2][2][4][2], const pg8::Unit& u, int wr, int wc, int fr, int fq, const Pre& pre) const {
        const int row0 = u.pm * 256 + wr * 64 + fr, col0 = u.pn() * 256 + wc * 32 + 8 * fq;
        const int pn = u.pn();
#pragma unroll
        for (int ai = 0; ai < 2; ++ai)
#pragma unroll
            for (int m = 0; m < 4; ++m) {
                const int row = row0 + ai * 128 + m * 16;
                const float rs = rsqrtf(pre.s[ai * 4 + m] * (1.f / 1024.f) + NORM_EPS);
#pragma unroll
                for (int bj = 0; bj < 2; ++bj) {
                    const int c = col0 + bj * 128;
                    const f32x4 v0 = acc[ai][bj][m][0] * rs, v1 = acc[ai][bj][m][1] * rs;
                    u32x4 w; w.x = cvt_pk_bf16(v0.x, v0.y); w.y = cvt_pk_bf16(v0.z, v0.w); w.z = cvt_pk_bf16(v1.x, v1.y); w.w = cvt_pk_bf16(v1.z, v1.w);
                    float* fo = nullptr;
                    if (pn < 7) {
                        *(u32x4*)(PR + (size_t)row * RC + c) = w;
                        if (row < MP) { if ((row & (SEQ - 1)) == SEQ - 1) fo = out + O_PSH + (size_t)(row >> 13) * RC + c; }
                        else { const int r = row - MP; if ((r & 15) == 15) fo = out + O_SSH + (size_t)(r >> 4) * RC + c; }
                    } else {
                        const int ca = c - RC;
                        *(u32x4*)(PA + (size_t)row * AC + ca) = w;
                        if (pn >= 9) {
                            const int cc = ca - 512, isv = cc >> 9, c2 = cc & 511, h = c2 >> 6, d = c2 & 63;
                            if (row < MP) { const int t = row & (SEQ - 1), b = row >> 13;
                                if (t >= SEQ - 512) fo = out + (isv ? O_PV : O_PK) + ((size_t)(b * 8 + h) * 512 + (t - (SEQ - 512))) * 64 + d; }
                            else { const int r = row - MP, sb = r >> 4, st = r & 15;
                                fo = out + (isv ? O_SV : O_SK) + ((size_t)(sb * 8 + h) * 16 + st) * 64 + d; }
                        }
                    }
                    if (fo) { *(f32x4*)fo = v0; *(f32x4*)(fo + 4) = v1; }
                }
            }
    }
};

__device__ __forceinline__ void tr_item(const float* W, int K, int N, bf16_t* WT, const float* scale, int mode, LAS float* scr, int item, int lane) {
    const int nblk = N / 32, kb = item / nblk, nb = item % nblk, k0 = 64 * kb, n0 = 32 * nb;
#pragma unroll 8
    for (int i = 0; i < 32; ++i) { const int kk = 2 * i + (lane >> 5); float v = W[(size_t)(k0 + kk) * N + n0 + (lane & 31)]; if (scale) v *= scale[k0 + kk]; scr[kk * 33 + (lane & 31)] = v; }
    asm volatile("s_waitcnt lgkmcnt(0)" ::: "memory");
    const int c = lane & 7;
#pragma unroll
    for (int j = 0; j < 4; ++j) { const int n = (lane >> 3) + 8 * j; const LAS float* s = scr + (8 * c) * 33 + n;
        u32x4 o; o.x = cvt_pk_bf16(s[0 * 33], s[1 * 33]); o.y = cvt_pk_bf16(s[2 * 33], s[3 * 33]); o.z = cvt_pk_bf16(s[4 * 33], s[5 * 33]); o.w = cvt_pk_bf16(s[6 * 33], s[7 * 33]);
        const int ng = n0 + n; const int rr = mode == 0 ? ng : (((ng >> 7) << 8) + (ng & 127) + (mode == 2 ? 128 : 0));
        *(u32x4*)(WT + (size_t)rr * K + k0 + 8 * c) = o; }
    asm volatile("s_waitcnt lgkmcnt(0)" ::: "memory");
}

struct Params { const float* in[30]; float* out; unsigned char* ws; int ph_lo, ph_hi; };

__device__ __forceinline__ void phase0(const Params& p, LAS unsigned char* lds, int gw, int NGW, int wave, int lane) {
    unsigned char* ws = p.ws;
    LAS float* scr = (LAS float*)(lds + wave * 8448);
    constexpr int I_GU = (D / 64) * (FF / 32), I_DN = (FF / 64) * (D / 32), I_IN = (D / 64) * (NIN / 32), I_OUT = (D / 64) * (D / 32), I_L = 16, I_GL = 32;
    constexpr int NITEMS = 4 * I_GU + 2 * I_DN + I_IN + I_OUT + 2 * I_L + I_GL;
    for (int it = gw; it < NITEMS; it += NGW) {
        int r = it;
        if (r < I_GU) { tr_item(p.in[7], D, FF, (bf16_t*)(ws + WS_WGU1), p.in[6], 1, scr, r, lane); continue; } r -= I_GU;
        if (r < I_GU) { tr_item(p.in[8], D, FF, (bf16_t*)(ws + WS_WGU1), p.in[6], 2, scr, r, lane); continue; } r -= I_GU;
        if (r < I_DN) { tr_item(p.in[9], FF, D, (bf16_t*)(ws + WS_WD1), nullptr, 0, scr, r, lane); continue; } r -= I_DN;
        if (r < I_IN) { tr_item(p.in[11], D, NIN, (bf16_t*)(ws + WS_WIN), p.in[10], 0, scr, r, lane); continue; } r -= I_IN;
        if (r < I_OUT) { tr_item(p.in[24], D, D, (bf16_t*)(ws + WS_WOUT), nullptr, 0, scr, r, lane); continue; } r -= I_OUT;
        if (r < I_GU) { tr_item(p.in[26], D, FF, (bf16_t*)(ws + WS_WGU2), p.in[25], 1, scr, r, lane); continue; } r -= I_GU;
        if (r < I_GU) { tr_item(p.in[27], D, FF, (bf16_t*)(ws + WS_WGU2), p.in[25], 2, scr, r, lane); continue; } r -= I_GU;
        if (r < I_DN) { tr_item(p.in[28], FF, D, (bf16_t*)(ws + WS_WD2), nullptr, 0, scr, r, lane); continue; } r -= I_DN;
        if (r < I_L) { tr_item(p.in[14], 64, 512, (bf16_t*)(ws + WS_WL), nullptr, 0, scr, r, lane); continue; } r -= I_L;
        if (r < I_L) { tr_item(p.in[16], 64, 512, (bf16_t*)(ws + WS_AL), nullptr, 0, scr, r, lane); continue; } r -= I_L;
        tr_item(p.in[17], 128, 512, (bf16_t*)(ws + WS_GL), nullptr, 0, scr, r, lane);
    }
    bf16_t* XB = (bf16_t*)(ws + WS_XB);
    float* SLAB = (float*)(ws + WS_SLAB);
    float* ss1 = (float*)(ws + WS_SS1);
    for (int m = gw; m < M; m += NGW) {
        const float* xrow = m < MP ? p.in[0] + (size_t)m * D : p.in[1] + (size_t)(m - MP) * D;
        const f32x4* xr = (const f32x4*)xrow + lane;
        f32x4 v[4]; float s = 0.f;
#pragma unroll
        for (int j = 0; j < 4; ++j) { v[j] = xr[64 * j]; s += v[j].x * v[j].x + v[j].y * v[j].y + v[j].z * v[j].z + v[j].w * v[j].w; }
        s = wave_sum(s);
        if (lane == 0) ss1[m] = s;
        if (m >= MP) { f32x4* xo = (f32x4*)(p.out + (size_t)m * D) + lane;
#pragma unroll
            for (int j = 0; j < 4; ++j) xo[64 * j] = v[j]; }
        u32x2* o8 = (u32x2*)(XB + (size_t)m * D) + lane;
#pragma unroll
        for (int j = 0; j < 4; ++j) { u32x2 o; o.x = cvt_pk_bf16(v[j].x, v[j].y); o.y = cvt_pk_bf16(v[j].z, v[j].w); o8[64 * j] = o; }
    }
    float* ssz = (float*)(ws + WS_SS2);
    for (int i = gw * 64 + lane; i < 3 * M; i += NGW * 64) ssz[i] = 0.f;
}

__device__ __forceinline__ float ld_prev(const bf16_t* PR, const float* sshift, int row, int col) {
    if (row < MP) { if ((row & (SEQ - 1)) == 0) return 0.f; return bf2f(PR[(size_t)(row - 1) * RC + col]); }
    const int r = row - MP; if ((r & 15) == 0) return sshift[(size_t)(r >> 4) * RC + col];
    return bf2f(PR[(size_t)(row - 1) * RC + col]);
}
__device__ __forceinline__ void up8(const u32x4 u, float (&f)[8]) { f[0] = bflo(u.x); f[1] = bfhi(u.x); f[2] = bflo(u.y); f[3] = bfhi(u.y); f[4] = bflo(u.z); f[5] = bfhi(u.z); f[6] = bflo(u.w); f[7] = bfhi(u.w); }
__device__ __forceinline__ void ld8f(const float* p, float (&f)[8]) { const f32x4 a = *(const f32x4*)p, b = *(const f32x4*)(p + 4); f[0] = a.x; f[1] = a.y; f[2] = a.z; f[3] = a.w; f[4] = b.x; f[5] = b.y; f[6] = b.z; f[7] = b.w; }
__device__ __forceinline__ u32x4 pk8(const float (&o)[8]) { u32x4 w; w.x = cvt_pk_bf16(o[0], o[1]); w.y = cvt_pk_bf16(o[2], o[3]); w.z = cvt_pk_bf16(o[4], o[5]); w.w = cvt_pk_bf16(o[6], o[7]); return w; }
constexpr int LW_PITCH = 144, LG_PITCH = 272, LW_OFF = 0, LA_OFF = 64 * LW_PITCH, LGL_OFF = 2 * 64 * LW_PITCH;
constexpr int PT_OFF = 36864;
constexpr int PT_MU = 0, PT_W0 = 1792, PT_A0 = 2304, PT_KK = 2816, PT_KA = 3328, PT_RK = 3840, PT_N = 4352;
__device__ __forceinline__ void prep_load_params(LAS unsigned char* lds, const Params& p, int tid) {
    LAS float* PT = (LAS float*)(lds + PT_OFF);
    for (int i = tid; i < PT_N; i += 512) {
        float v;
        if (i < PT_W0) v = p.in[12][i]; else if (i < PT_A0) v = p.in[13][i - PT_W0]; else if (i < PT_KK) v = p.in[15][i - PT_A0];
        else if (i < PT_KA) v = p.in[18][i - PT_KK]; else if (i < PT_RK) v = p.in[19][i - PT_KA]; else v = p.in[20][i - PT_RK];
        PT[i] = v;
    }
    __syncthreads();
}
__device__ __forceinline__ void lds8f(const LAS float* q, float (&f)[8]) { const f32x4 a = *(const LAS f32x4*)q, b = *(const LAS f32x4*)(q + 4); f[0] = a.x; f[1] = a.y; f[2] = a.z; f[3] = a.w; f[4] = b.x; f[5] = b.y; f[6] = b.z; f[7] = b.w; }
__device__ __forceinline__ void prep_unit(LAS unsigned char* lds, const Params& p, int u, int lane, int tid, int h_lo, int h_hi) {
    unsigned char* ws = p.ws;
    const bf16_t* PR = (const bf16_t*)(ws + WS_PR);
    const float* sshift = p.in[2];
    const LAS float* PT = (const LAS float*)(lds + PT_OFF);
    const bf16_t* WL = (const bf16_t*)(ws + WS_WL); const bf16_t* AL = (const bf16_t*)(ws + WS_AL); const bf16_t* GL = (const bf16_t*)(ws + WS_GL);
    float* SW = (float*)(ws + WS_XB);
    bf16_t* SR = (bf16_t*)(ws + WS_S5); bf16_t* SK = (bf16_t*)(ws + WS_S5 + S5B); bf16_t* SV = (bf16_t*)(ws + WS_S5 + 2 * S5B);
    bf16_t* SKK = (bf16_t*)(ws + WS_S5 + 3 * S5B); bf16_t* SB = (bf16_t*)(ws + WS_S5 + 4 * S5B); bf16_t* SG = (bf16_t*)(ws + WS_G);
    float* BON = (float*)(ws + WS_BON);
    const int row0 = u * 16, i16 = lane & 15, quad = lane >> 4;
    const int row = row0 + i16;
    const bool zero_prev = row < MP && (row & (SEQ - 1)) == 0;
    const bool st_prev = row >= MP && ((row - MP) & 15) == 0;
    const bf16_t* prow = PR + (size_t)row * RC;
    const bf16_t* pprev = PR + (size_t)(zero_prev || st_prev ? row : row - 1) * RC;
    const float* sprev = sshift + (size_t)(st_prev ? ((row - MP) >> 4) : 0) * RC;
    auto lerp8 = [&](const u32x4 cu, const u32x4 pu, int col, float (&x)[8]) {
        float cf[8], pf[8], mf[8];
        up8(cu, cf);
        if (st_prev) ld8f(sprev + col, pf); else up8(pu, pf);
        lds8f(PT + PT_MU + col, mf);
#pragma unroll
        for (int j = 0; j < 8; ++j) { const float pv = zero_prev ? 0.f : pf[j]; x[j] = cf[j] + (pv - cf[j]) * mf[j]; }
    };
    bf16x8 Bf[8];
    {
        u32x4 cu[8], pu[8];
#pragma unroll
        for (int s8 = 0; s8 < 8; ++s8) { const int col = 1536 + s8 * 32 + quad * 8; cu[s8] = *(const u32x4*)(prow + col); pu[s8] = *(const u32x4*)(pprev + col); }
#pragma unroll
        for (int s8 = 0; s8 < 8; ++s8) {
            float xv[8]; lerp8(cu[s8], pu[s8], 1536 + s8 * 32 + quad * 8, xv);
#pragma unroll
            for (int j = 0; j < 8; ++j) {
                if (s8 < 2) xv[j] = 1.f - 2.f * __builtin_amdgcn_rcpf(1.f + fast_exp(2.f * xv[j]));
                else if (s8 >= 4) xv[j] = sigmoidf_(xv[j]);
            }
            Bf[s8] = __builtin_bit_cast(bf16x8, pk8(xv));
        }
    }
#pragma unroll 1
    for (int h = h_lo; h < h_hi; ++h) {
        __syncthreads();
        { const int r = tid >> 3, ch = tid & 7;
          *(LAS u32x4*)(lds + LW_OFF + r * LW_PITCH + ch * 16) = *(const u32x4*)(WL + (size_t)(h * 64 + r) * 64 + ch * 8);
          *(LAS u32x4*)(lds + LA_OFF + r * LW_PITCH + ch * 16) = *(const u32x4*)(AL + (size_t)(h * 64 + r) * 64 + ch * 8);
#pragma unroll
          for (int i = 0; i < 2; ++i) { const int pz = tid + 512 * i, rr = pz >> 4, c2 = pz & 15;
              *(LAS u32x4*)(lds + LGL_OFF + rr * LG_PITCH + c2 * 16) = *(const u32x4*)(GL + (size_t)(h * 64 + rr) * 128 + c2 * 8); } }
        __syncthreads();
        float ssq = 0.f, bs = 0.f;
#pragma unroll 1
        for (int g2 = 0; g2 < 2; ++g2) {
            const int cbase = h * 64 + g2 * 32;
            const int c0 = cbase + 8 * quad;
            const size_t o = (size_t)row * RW + c0;
            const u32x4 rcu = *(const u32x4*)(prow + c0), kcu = *(const u32x4*)(prow + 512 + c0), vcu = *(const u32x4*)(prow + 1024 + c0);
            const u32x4 rpu = *(const u32x4*)(pprev + c0), kpu = *(const u32x4*)(pprev + 512 + c0), vpu = *(const u32x4*)(pprev + 1024 + c0);
            f32x4 aW[2], aA[2], aG[2];
#pragma unroll
            for (int t = 0; t < 2; ++t) {
                const int rl = g2 * 32 + 8 * (i16 >> 2) + 4 * t + (i16 & 3);
                aW[t] = (f32x4){0.f, 0.f, 0.f, 0.f}; aA[t] = aW[t]; aG[t] = aW[t];
#pragma unroll
                for (int ks = 0; ks < 2; ++ks) {
                    const bf16x8 fw = *(const LAS bf16x8*)(lds + LW_OFF + rl * LW_PITCH + (ks * 32 + quad * 8) * 2);
                    const bf16x8 fa = *(const LAS bf16x8*)(lds + LA_OFF + rl * LW_PITCH + (ks * 32 + quad * 8) * 2);
                    aW[t] = __builtin_amdgcn_mfma_f32_16x16x32_bf16(fw, Bf[ks], aW[t], 0, 0, 0);
                    aA[t] = __builtin_amdgcn_mfma_f32_16x16x32_bf16(fa, Bf[2 + ks], aA[t], 0, 0, 0);
                }
#pragma unroll
                for (int ks = 0; ks < 4; ++ks) {
                    const bf16x8 fg = *(const LAS bf16x8*)(lds + LGL_OFF + rl * LG_PITCH + (ks * 32 + quad * 8) * 2);
                    aG[t] = __builtin_amdgcn_mfma_f32_16x16x32_bf16(fg, Bf[4 + ks], aG[t], 0, 0, 0);
                }
            }
            float gg[8], dec[8], av[8], k4[8], kru[8], kbu[8], rs[8], vs[8];
#pragma unroll
            for (int e = 0; e < 8; ++e) gg[e] = aG[e >> 2][e & 3];
            { float w0v[8]; lds8f(PT + PT_W0 + c0, w0v);
#pragma unroll
              for (int e = 0; e < 8; ++e) { const float z = -(w0v[e] + aW[e >> 2][e & 3]);
                  const float sp = fmaxf(z, 0.f) + __logf(1.f + fast_exp(-fabsf(z)));
                  dec[e] = fast_exp(-fast_exp(-sp - 0.5f)); } }
            { float a0v[8]; lds8f(PT + PT_A0 + c0, a0v);
#pragma unroll
              for (int e = 0; e < 8; ++e) av[e] = sigmoidf_(a0v[e] + aA[e >> 2][e & 3]); }
            { float ks_[8], kkv[8], kav[8]; lerp8(kcu, kpu, 512 + c0, ks_); lds8f(PT + PT_KK + c0, kkv); lds8f(PT + PT_KA + c0, kav);
#pragma unroll
              for (int e = 0; e < 8; ++e) { const float kr = ks_[e] * kkv[e]; kru[e] = kr; kbu[e] = kr * av[e]; ssq += kr * kr; k4[e] = ks_[e] * (1.f + (av[e] - 1.f) * kav[e]); } }
            { float rkv[8]; lerp8(rcu, rpu, c0, rs); lds8f(PT + PT_RK + c0, rkv);
#pragma unroll
              for (int e = 0; e < 8; ++e) bs += rs[e] * k4[e] * rkv[e]; }
            lerp8(vcu, vpu, 1024 + c0, vs);
            *(u32x4*)(SG + o) = pk8(gg);
            *(f32x4*)(SW + o) = (f32x4){dec[0], dec[1], dec[2], dec[3]}; *(f32x4*)(SW + o + 4) = (f32x4){dec[4], dec[5], dec[6], dec[7]};
            *(u32x4*)(SK + o) = pk8(k4); *(u32x4*)(SKK + o) = pk8(kru); *(u32x4*)(SB + o) = pk8(kbu);
            *(u32x4*)(SR + o) = pk8(rs); *(u32x4*)(SV + o) = pk8(vs);
        }
        ssq += __shfl_xor(ssq, 16); ssq += __shfl_xor(ssq, 32);
        bs += __shfl_xor(bs, 16); bs += __shfl_xor(bs, 32);
        if (quad == 0) { BON[(size_t)row * 8 + h] = bs; ((float*)(ws + WS_INV))[(size_t)row * 8 + h] = rsqrtf(fmaxf(ssq, 1e-24f)); }
    }
}

__device__ __forceinline__ bf16x8 tr_read2(unsigned a0, unsigned a1) {
    u32x2 r0, r1;
    asm volatile("ds_read_b64_tr_b16 %0, %2\n\tds_read_b64_tr_b16 %1, %3\n\ts_waitcnt lgkmcnt(0)" : "=&v"(r0), "=&v"(r1) : "v"(a0), "v"(a1) : "memory");
    u32x4 w; w.x = r0.x; w.y = r0.y; w.z = r1.x; w.w = r1.y;
    return __builtin_bit_cast(bf16x8, w);
}
__device__ __forceinline__ void tr_read8(unsigned a, bf16x8 (&Av)[4]) {
    u32x2 r0, r1, r2, r3, r4, r5, r6, r7;
    asm volatile("ds_read_b64_tr_b16 %0, %8\n\tds_read_b64_tr_b16 %1, %8 offset:2304\n\t"
                 "ds_read_b64_tr_b16 %2, %8 offset:32\n\tds_read_b64_tr_b16 %3, %8 offset:2336\n\t"
                 "ds_read_b64_tr_b16 %4, %8 offset:64\n\tds_read_b64_tr_b16 %5, %8 offset:2368\n\t"
                 "ds_read_b64_tr_b16 %6, %8 offset:96\n\tds_read_b64_tr_b16 %7, %8 offset:2400\n\ts_waitcnt lgkmcnt(0)"
                 : "=&v"(r0), "=&v"(r1), "=&v"(r2), "=&v"(r3), "=&v"(r4), "=&v"(r5), "=&v"(r6), "=&v"(r7) : "v"(a) : "memory");
    u32x4 w;
    w.x = r0.x; w.y = r0.y; w.z = r1.x; w.w = r1.y; Av[0] = __builtin_bit_cast(bf16x8, w);
    w.x = r2.x; w.y = r2.y; w.z = r3.x; w.w = r3.y; Av[1] = __builtin_bit_cast(bf16x8, w);
    w.x = r4.x; w.y = r4.y; w.z = r5.x; w.w = r5.y; Av[2] = __builtin_bit_cast(bf16x8, w);
    w.x = r6.x; w.y = r6.y; w.z = r7.x; w.w = r7.y; Av[3] = __builtin_bit_cast(bf16x8, w);
}
constexpr int ATT_WL = 10496, VPITCH = 144;
constexpr int QT = 2;
__device__ __forceinline__ void attn_prompt_unit(LAS unsigned char* wl, bf16_t* PA, const float* relb, int u, int lane) {
    const int h = u & 7, qh = (u >> 3) & 1, cb = u >> 4, c = cb & 127, b = cb >> 7;
    const int i16 = lane & 15, quad = lane >> 4;
    const size_t c0 = (size_t)b * SEQ + (size_t)c * 64;
    const size_t q0 = c0 + qh * 32;
    LAS float* tab = (LAS float*)(wl + 9216);
    for (int i = lane; i < 257; i += 64) tab[i] = relb[h * 257 + i] * 1.44269504089f;
    const float tab0 = relb[h * 257] * 1.44269504089f;
    bf16x8 Bq[QT][2];
#pragma unroll
    for (int qt = 0; qt < QT; ++qt)
#pragma unroll
        for (int ks = 0; ks < 2; ++ks) Bq[qt][ks] = *(const bf16x8*)(PA + (q0 + qt * 16 + i16) * AC + h * 64 + ks * 32 + quad * 8);
    f32x4 O[4][QT];
    float mrun[QT], lrun[QT];
#pragma unroll
    for (int qt = 0; qt < QT; ++qt) { mrun[qt] = -1e30f; lrun[qt] = 0.f;
#pragma unroll
        for (int dt = 0; dt < 4; ++dt) O[dt][qt] = (f32x4){0.f, 0.f, 0.f, 0.f}; }
    const unsigned wbase = (unsigned)(unsigned long)wl;
    const int kt0 = (c < 8 ? 8 - c : 0);
    bf16x8 Kc[4][2]; u32x4 Vc[8];
    auto issue_tile = [&](int kt, bf16x8 (&Kx)[4][2], u32x4 (&Vx)[8]) {
        const size_t k0 = c0 - (size_t)(8 - kt) * 64;
#pragma unroll
        for (int kti = 0; kti < 4; ++kti) { const bf16_t* kp = PA + (k0 + kti * 16 + i16) * AC + 512 + h * 64 + quad * 8;
            Kx[kti][0] = *(const bf16x8*)kp; Kx[kti][1] = *(const bf16x8*)(kp + 32); }
#pragma unroll
        for (int i = 0; i < 8; ++i) { const int pz = lane + 64 * i, key = pz >> 3, ch = pz & 7;
            Vx[i] = *(const u32x4*)(PA + (k0 + key) * AC + 1024 + h * 64 + ch * 8); }
    };
    issue_tile(kt0, Kc, Vc);
    for (int kt = kt0; kt <= 8; ++kt) {
#pragma unroll
        for (int i = 0; i < 8; ++i) { const int pz = lane + 64 * i, key = pz >> 3, ch = pz & 7; *(LAS u32x4*)(wl + key * VPITCH + ch * 16) = Vc[i]; }
        bf16x8 Ku[4][2];
#pragma unroll
        for (int kti = 0; kti < 4; ++kti) { Ku[kti][0] = Kc[kti][0]; Ku[kti][1] = Kc[kti][1]; }
        if (kt < 8) issue_tile(kt + 1, Kc, Vc);
        f32x4 St[4][QT];
#pragma unroll
        for (int kti = 0; kti < 4; ++kti) {
#pragma unroll
            for (int qt = 0; qt < QT; ++qt) {
                f32x4 s = {0.f, 0.f, 0.f, 0.f};
                s = __builtin_amdgcn_mfma_f32_16x16x32_bf16(Ku[kti][0], Bq[qt][0], s, 0, 0, 0);
                s = __builtin_amdgcn_mfma_f32_16x16x32_bf16(Ku[kti][1], Bq[qt][1], s, 0, 0, 0);
                St[kti][qt] = s;
            }
        }
        const float sc = 0.125f * 1.44269504089f;
        if (kt < 6) {
#pragma unroll
            for (int kti = 0; kti < 4; ++kti)
#pragma unroll
                for (int qt = 0; qt < QT; ++qt) St[kti][qt] = St[kti][qt] * sc + tab0;
        } else {
#pragma unroll
            for (int kti = 0; kti < 4; ++kti)
#pragma unroll
                for (int qt = 0; qt < QT; ++qt)
#pragma unroll
                    for (int j = 0; j < 4; ++j) {
                        int rel = (kt - 8) * 64 + kti * 16 + quad * 4 + j - (qh * 32 + qt * 16 + i16);
                        rel = rel < -128 ? -128 : (rel > 128 ? 128 : rel);
                        St[kti][qt][j] = St[kti][qt][j] * sc + tab[rel + 128];
                    }
        }
#pragma unroll
        for (int qt = 0; qt < QT; ++qt) {
            float mx = -1e30f;
#pragma unroll
            for (int kti = 0; kti < 4; ++kti)
#pragma unroll
                for (int j = 0; j < 4; ++j) mx = fmaxf(mx, St[kti][qt][j]);
            mx = fmaxf(mx, __shfl_xor(mx, 16)); mx = fmaxf(mx, __shfl_xor(mx, 32));
            const float mnew = fmaxf(mrun[qt], mx);
            const float alpha = __builtin_amdgcn_exp2f(mrun[qt] - mnew);
            mrun[qt] = mnew;
            float ps = 0.f;
#pragma unroll
            for (int kti = 0; kti < 4; ++kti)
#pragma unroll
                for (int j = 0; j < 4; ++j) { const float pv = __builtin_amdgcn_exp2f(St[kti][qt][j] - mnew); St[kti][qt][j] = pv; ps += pv; }
            lrun[qt] = lrun[qt] * alpha + ps;
#pragma unroll
            for (int dt = 0; dt < 4; ++dt) O[dt][qt] = O[dt][qt] * alpha;
        }
#pragma unroll
        for (int ks2 = 0; ks2 < 2; ++ks2) {
            bf16x8 Bp[QT];
#pragma unroll
            for (int qt = 0; qt < QT; ++qt) {
                u32x4 w; const f32x4 p0 = St[2 * ks2][qt], p1 = St[2 * ks2 + 1][qt];
                w.x = cvt_pk_bf16(p0.x, p0.y); w.y = cvt_pk_bf16(p0.z, p0.w); w.z = cvt_pk_bf16(p1.x, p1.y); w.w = cvt_pk_bf16(p1.z, p1.w);
                Bp[qt] = __builtin_bit_cast(bf16x8, w);
            }
            bf16x8 Av[4];
            tr_read8(wbase + (unsigned)((32 * ks2 + 4 * quad + (i16 >> 2)) * VPITCH + (4 * (lane & 3)) * 2), Av);
#pragma unroll
            for (int dt = 0; dt < 4; ++dt)
#pragma unroll
                for (int qt = 0; qt < QT; ++qt) O[dt][qt] = __builtin_amdgcn_mfma_f32_16x16x32_bf16(Av[dt], Bp[qt], O[dt][qt], 0, 0, 0);
        }
    }
#pragma unroll
    for (int qt = 0; qt < QT; ++qt) {
        float l = lrun[qt]; l += __shfl_xor(l, 16); l += __shfl_xor(l, 32);
        const float inv = 1.f / l;
#pragma unroll
        for (int dt = 0; dt < 4; ++dt) {
            const f32x4 o = O[dt][qt] * inv;
            u32x2 w; w.x = cvt_pk_bf16(o.x, o.y); w.y = cvt_pk_bf16(o.z, o.w);
            *(u32x2*)(PA + (q0 + qt * 16 + i16) * AC + h * 64 + dt * 16 + quad * 4) = w;
        }
    }
}
__device__ __forceinline__ void attn_sample_unit(LAS unsigned char* wl, const Params& p, int u, int lane) {
    bf16_t* PA = (bf16_t*)(p.ws + WS_PA);
    const int i = u & 15, h = (u >> 4) & 7, sb = u >> 7;
    const size_t qrow = (size_t)MP + sb * 16 + i;
    LAS float* qs = (LAS float*)wl; LAS float* pb = (LAS float*)(wl + 256);
    qs[lane] = bf2f(PA[qrow * AC + h * 64 + lane]);
    const float* ck = p.in[4] + (size_t)(sb * 8 + h) * 512 * 64; const float* cv = p.in[5] + (size_t)(sb * 8 + h) * 512 * 64;
    const float* nk = p.out + O_SK + (size_t)(sb * 8 + h) * 16 * 64; const float* nv = p.out + O_SV + (size_t)(sb * 8 + h) * 16 * 64;
    const float* tabg = p.in[23] + h * 257;
    float mx = -1e30f;
#pragma unroll 1
    for (int ps = 0; ps < 9; ++ps) {
        const int j = ps * 64 + lane;
        if (j < 528) {
            const float* kr = j < 512 ? ck + (size_t)j * 64 : nk + (size_t)(j - 512) * 64;
            float a = 0.f;
#pragma unroll
            for (int d = 0; d < 64; d += 4) { const f32x4 kv = *(const f32x4*)(kr + d); const f32x4 qv = *(const LAS f32x4*)(qs + d); a += kv.x * qv.x + kv.y * qv.y + kv.z * qv.z + kv.w * qv.w; }
            int rel = j - 512 - i; rel = rel < -128 ? -128 : (rel > 128 ? 128 : rel);
            const float s = a * 0.125f + tabg[rel + 128];
            pb[j] = s; mx = fmaxf(mx, s);
        }
    }
    mx = wave_max(mx);
    float sum = 0.f;
#pragma unroll 1
    for (int ps = 0; ps < 9; ++ps) { const int j = ps * 64 + lane; if (j < 528) { const float e = fast_exp(pb[j] - mx); sum += e; pb[j] = e; } }
    sum = wave_sum(sum);
    float o = 0.f;
    float o1 = 0.f, o2 = 0.f, o3 = 0.f;
#pragma unroll 8
    for (int j = 0; j < 512; j += 4) { o += pb[j] * cv[(size_t)j * 64 + lane]; o1 += pb[j + 1] * cv[(size_t)(j + 1) * 64 + lane]; o2 += pb[j + 2] * cv[(size_t)(j + 2) * 64 + lane]; o3 += pb[j + 3] * cv[(size_t)(j + 3) * 64 + lane]; }
#pragma unroll
    for (int j = 0; j < 16; ++j) o += pb[512 + j] * nv[(size_t)j * 64 + lane];
    o += o1 + o2 + o3;
    PA[qrow * AC + h * 64 + lane] = f2bf(o / sum);
}

constexpr int STEP_B = 1344;
template <int NS>
__device__ __forceinline__ void scan_unit(LAS unsigned char* lds, const Params& p, size_t row0, int T, int h, int vq, const float* s_init, float* s_out, int tid) {
    unsigned char* ws = p.ws;
    const float* SW = (const float*)(ws + WS_XB);
    const bf16_t* SR = (const bf16_t*)(ws + WS_S5); const bf16_t* SK = (const bf16_t*)(ws + WS_S5 + S5B); const bf16_t* SV = (const bf16_t*)(ws + WS_S5 + 2 * S5B);
    const bf16_t* SKK = (const bf16_t*)(ws + WS_S5 + 3 * S5B); const bf16_t* SB = (const bf16_t*)(ws + WS_S5 + 4 * S5B);
    float* Y = (float*)(ws + WS_PR);
    constexpr int BUF_B = NS * STEP_B;
    LAS unsigned char* ybase = lds + 2 * 32 * STEP_B;
    const int nchunks = T / NS;
    const bool loader = tid >= 256;
    const int L = tid - 256;
    const int lane = tid & 63, wv = tid >> 6, vi = lane >> 4, kj = lane & 15, rloc = wv * 4 + vi;
    f32x2 S01 = {0.f, 0.f}, S23 = {0.f, 0.f};
    if (!loader && s_init) { const f32x4 s = *(const f32x4*)(s_init + (size_t)(vq * 16 + rloc) * 64 + 4 * kj); S01 = (f32x2){s.x, s.y}; S23 = (f32x2){s.z, s.w}; }
    f32x4 gw_[(NS * 16 + 255) / 256]; u32x4 gkk = {0u, 0u, 0u, 0u}, gb = gkk, gk = gkk, gr = gkk, gv = gkk; float ginv = 0.f;
    const float* INV = (const float*)(ws + WS_INV);
#pragma unroll
    for (int i = 0; i < (NS * 16 + 255) / 256; ++i) gw_[i] = (f32x4){0.f, 0.f, 0.f, 0.f};
    auto issue_chunk = [&](int c) {
        const size_t r0 = row0 + (size_t)c * NS;
#pragma unroll
        for (int i = 0; i < (NS * 16 + 255) / 256; ++i) { const int pz = L + 256 * i; if (pz < NS * 16) { const int st = pz >> 4, o = pz & 15;
            gw_[i] = *(const f32x4*)(SW + (r0 + st) * RW + h * 64 + o * 4); } }
        if (L < NS * 8) { const int st = L >> 3, o = L & 7; const size_t g = (r0 + st) * RW + h * 64 + o * 8;
            gkk = *(const u32x4*)(SKK + g); gb = *(const u32x4*)(SB + g); gk = *(const u32x4*)(SK + g); gr = *(const u32x4*)(SR + g); ginv = INV[(r0 + st) * 8 + h]; }
        if (L < NS * 2) { const int st = L >> 1, hf = L & 1; gv = *(const u32x4*)(SV + (r0 + st) * RW + h * 64 + vq * 16 + hf * 8); }
    };
    auto commit_chunk = [&](int c) {
        LAS unsigned char* buf = lds + (c & 1) * 32 * STEP_B;
#pragma unroll
        for (int i = 0; i < (NS * 16 + 255) / 256; ++i) { const int pz = L + 256 * i; if (pz < NS * 16) { const int st = pz >> 4, o = pz & 15;
            *(LAS f32x4*)(buf + st * STEP_B + o * 16) = gw_[i]; } }
        if (L < NS * 8) { const int st = L >> 3, o = L & 7;
            const u32x4 a = gkk, b = gb, k = gk, r = gr;
            LAS unsigned char* d = buf + st * STEP_B + o * 32;
            *(LAS f32x4*)(d + 256) = (f32x4){bflo(a.x), bfhi(a.x), bflo(a.y), bfhi(a.y)} * ginv; *(LAS f32x4*)(d + 256 + 16) = (f32x4){bflo(a.z), bfhi(a.z), bflo(a.w), bfhi(a.w)} * ginv;
            *(LAS f32x4*)(d + 512) = (f32x4){bflo(b.x), bfhi(b.x), bflo(b.y), bfhi(b.y)} * ginv; *(LAS f32x4*)(d + 512 + 16) = (f32x4){bflo(b.z), bfhi(b.z), bflo(b.w), bfhi(b.w)} * ginv;
            *(LAS f32x4*)(d + 768) = (f32x4){bflo(k.x), bfhi(k.x), bflo(k.y), bfhi(k.y)}; *(LAS f32x4*)(d + 768 + 16) = (f32x4){bflo(k.z), bfhi(k.z), bflo(k.w), bfhi(k.w)};
            *(LAS f32x4*)(d + 1024) = (f32x4){bflo(r.x), bfhi(r.x), bflo(r.y), bfhi(r.y)}; *(LAS f32x4*)(d + 1024 + 16) = (f32x4){bflo(r.z), bfhi(r.z), bflo(r.w), bfhi(r.w)}; }
        if (L < NS * 2) { const int st = L >> 1, hf = L & 1; const u32x4 v = gv;
            LAS unsigned char* d = buf + st * STEP_B + 1280 + hf * 32;
            *(LAS f32x4*)d = (f32x4){bflo(v.x), bfhi(v.x), bflo(v.y), bfhi(v.y)}; *(LAS f32x4*)(d + 16) = (f32x4){bflo(v.z), bfhi(v.z), bflo(v.w), bfhi(v.w)}; }
    };
    auto flush_y = [&](int c) {
        if (L < NS * 4) { const int st = L >> 2, q = L & 3; const f32x4 v = *(const LAS f32x4*)(ybase + (c & 1) * 2048 + st * 64 + q * 16);
            *(f32x4*)(Y + (row0 + (size_t)c * NS + st) * RW + h * 64 + vq * 16 + q * 4) = v; }
    };
#define SCAN_BAR() do { asm volatile("s_waitcnt lgkmcnt(0)" ::: "memory"); __builtin_amdgcn_s_barrier(); asm volatile("" ::: "memory"); } while (0)
    if (loader) { issue_chunk(0); commit_chunk(0); if (nchunks > 1) issue_chunk(1); }
    SCAN_BAR();
    for (int c = 0; c < nchunks; ++c) {
        if (loader) {
            if (c + 1 < nchunks) commit_chunk(c + 1);
            if (c + 2 < nchunks) issue_chunk(c + 2);
            if (c > 0) flush_y(c - 1);
        } else {
            LAS unsigned char* buf = lds + (c & 1) * 32 * STEP_B;
            LAS float* yb = (LAS float*)(ybase + (c & 1) * 2048);
            f32x4 w4 = *(const LAS f32x4*)(buf + kj * 16), kk4 = *(const LAS f32x4*)(buf + 256 + kj * 16), b4 = *(const LAS f32x4*)(buf + 512 + kj * 16),
                  k4 = *(const LAS f32x4*)(buf + 768 + kj * 16), r4 = *(const LAS f32x4*)(buf + 1024 + kj * 16);
            float vv = *(const LAS float*)(buf + 1280 + rloc * 4);
            float ykeep = 0.f, ypart = 0.f;
#pragma unroll
            for (int s = 0; s <= NS; ++s) {
                f32x4 w4n = w4, kk4n = kk4, b4n = b4, k4n = k4, r4n = r4; float vvn = vv;
                if (s + 1 < NS) { LAS unsigned char* sp = buf + (s + 1) * STEP_B;
                    w4n = *(const LAS f32x4*)(sp + kj * 16); kk4n = *(const LAS f32x4*)(sp + 256 + kj * 16); b4n = *(const LAS f32x4*)(sp + 512 + kj * 16);
                    k4n = *(const LAS f32x4*)(sp + 768 + kj * 16); r4n = *(const LAS f32x4*)(sp + 1024 + kj * 16); vvn = *(const LAS float*)(sp + 1280 + rloc * 4); }
                float sa = 0.f;
                if (s < NS) { f32x2 t = S01 * (f32x2){kk4.x, kk4.y}; t = S23 * (f32x2){kk4.z, kk4.w} + t; sa = t.x + t.y; }
                float yr = ypart;
                sa += dppf<0xB1>(sa); yr += dppf<0xB1>(yr);
                sa += dppf<0x4E>(sa); yr += dppf<0x4E>(yr);
                sa += dppf<0x141>(sa); yr += dppf<0x141>(yr);
                sa += dppf<0x140>(sa); yr += dppf<0x140>(yr);
                if (s > 0) { ykeep = (kj == ((s - 1) & 15)) ? yr : ykeep;
                    if (((s - 1) & 15) == 15) yb[((s - 1) - 15 + kj) * 16 + rloc] = ykeep; }
                if (s < NS) {
                    const f32x2 vk01 = (f32x2){vv, vv} * (f32x2){k4.x, k4.y}, vk23 = (f32x2){vv, vv} * (f32x2){k4.z, k4.w};
                    S01 = S01 * (f32x2){w4.x, w4.y} + vk01; S23 = S23 * (f32x2){w4.z, w4.w} + vk23;
                    const f32x2 nsa = {-sa, -sa};
                    S01 = nsa * (f32x2){b4.x, b4.y} + S01; S23 = nsa * (f32x2){b4.z, b4.w} + S23;
                    f32x2 yy = S01 * (f32x2){r4.x, r4.y}; yy = S23 * (f32x2){r4.z, r4.w} + yy;
                    ypart = yy.x + yy.y;
                }
                w4 = w4n; kk4 = kk4n; b4 = b4n; k4 = k4n; r4 = r4n; vv = vvn;
            }
        }
        SCAN_BAR();
    }
    if (loader) flush_y(nchunks - 1);
    else *(f32x4*)(s_out + (size_t)(vq * 16 + rloc) * 64 + 4 * kj) = (f32x4){S01.x, S01.y, S23.x, S23.y};
    SCAN_BAR();
#undef SCAN_BAR
}

__device__ __forceinline__ void post_row(const Params& p, int row, int lane) {
    unsigned char* ws = p.ws;
    const float* Y = (const float*)(ws + WS_PR); const bf16_t* PA = (const bf16_t*)(ws + WS_PA); const bf16_t* SV = (const bf16_t*)(ws + WS_S5 + 2 * S5B);
    const bf16_t* SG = (const bf16_t*)(ws + WS_G); const float* BON = (const float*)(ws + WS_BON); bf16_t* MIX = (bf16_t*)(ws + WS_S5);
    const int c0 = lane * 8, h = lane >> 3;
    const f32x4 y0 = *(const f32x4*)(Y + (size_t)row * RW + c0), y1 = *(const f32x4*)(Y + (size_t)row * RW + c0 + 4);
    float yv[8] = {y0.x, y0.y, y0.z, y0.w, y1.x, y1.y, y1.z, y1.w};
    float s = 0.f;
#pragma unroll
    for (int j = 0; j < 8; ++j) s += yv[j];
    const float mean = row8_sum(s) * (1.f / 64.f);
    float s2 = 0.f;
#pragma unroll
    for (int j = 0; j < 8; ++j) { yv[j] -= mean; s2 += yv[j] * yv[j]; }
    const float rstd = rsqrtf(row8_sum(s2) * (1.f / 64.f) + GN_EPS);
    const u32x4 vu = *(const u32x4*)(SV + (size_t)row * RW + c0), gu = *(const u32x4*)(SG + (size_t)row * RW + c0);
    const float vf[8] = {bflo(vu.x), bfhi(vu.x), bflo(vu.y), bfhi(vu.y), bflo(vu.z), bfhi(vu.z), bflo(vu.w), bfhi(vu.w)};
    const float gf[8] = {bflo(gu.x), bfhi(gu.x), bflo(gu.y), bfhi(gu.y), bflo(gu.z), bfhi(gu.z), bflo(gu.w), bfhi(gu.w)};
    const float bd = BON[(size_t)row * 8 + h];
    const float* lw = p.in[21] + c0; const float* lb = p.in[22] + c0;
    float o[8];
#pragma unroll
    for (int j = 0; j < 8; ++j) o[j] = (yv[j] * rstd * lw[j] + lb[j] + bd * vf[j]) * gf[j];
    u32x4 w; w.x = cvt_pk_bf16(o[0], o[1]); w.y = cvt_pk_bf16(o[2], o[3]); w.z = cvt_pk_bf16(o[4], o[5]); w.w = cvt_pk_bf16(o[6], o[7]);
    *(u32x4*)(MIX + (size_t)row * D + c0) = w;
    *(u32x4*)(MIX + (size_t)row * D + 512 + c0) = *(const u32x4*)(PA + (size_t)row * AC + c0);
}


__device__ __forceinline__ void rowss_phase(const float* XR, float* ss, int gw, int NGW, int lane) {
    for (int m = gw; m < M; m += NGW) {
        const f32x4* xr = (const f32x4*)(XR + (size_t)m * D) + lane; float s = 0.f;
#pragma unroll
        for (int j = 0; j < 4; ++j) { const f32x4 v = xr[64 * j]; s += v.x * v.x + v.y * v.y + v.z * v.z + v.w * v.w; }
        s = wave_sum(s);
        if (lane == 0) ss[m] = s;
    }
}

__device__ __forceinline__ void fix_sample_rows(float* XR, const float* slab, int nsl, float scale, float* ssn, bf16_t* XBo, int gw, int NGW, int lane) {
    for (int m = MP + gw; m < M; m += NGW) {
        f32x4* xr = (f32x4*)(XR + (size_t)m * D) + lane; f32x4 v[4], a[4]; float s = 0.f;
#pragma unroll
        for (int j = 0; j < 4; ++j) { v[j] = xr[64 * j]; a[j] = (f32x4){0.f, 0.f, 0.f, 0.f}; }
        for (int q = 0; q < nsl; ++q) { const f32x4* sp = (const f32x4*)(slab + (size_t)q * (MS * D) + (size_t)(m - MP) * D) + lane;
#pragma unroll
            for (int j = 0; j < 4; ++j) a[j] += sp[64 * j]; }
#pragma unroll
        for (int j = 0; j < 4; ++j) { v[j] += scale * a[j]; xr[64 * j] = v[j]; s += v[j].x * v[j].x + v[j].y * v[j].y + v[j].z * v[j].z + v[j].w * v[j].w; }
        s = wave_sum(s);
        if (ssn && lane == 0) ssn[m] = s;
        if (XBo) { u32x2* o8 = (u32x2*)(XBo + (size_t)m * D) + lane;
#pragma unroll
            for (int j = 0; j < 4; ++j) { u32x2 o; o.x = cvt_pk_bf16(v[j].x, v[j].y); o.y = cvt_pk_bf16(v[j].z, v[j].w); o8[64 * j] = o; } }
    }
}

#define XB_TMO      128
#define XB_XCNT(j)  (256  + 64 * (j))
#define XB_XSUB(j)  (1280 + 64 * (j))
#define XB_XGEN(j)  (2304 + 64 * (j))
#define XB_TOP      3328
#define XB_TOPGEN   3392
#define XCD_BAR_WORDS 3456
#define XB_SPIN_CAP (1u << 22)
__device__ __forceinline__ unsigned xb_ld(unsigned* p)              { return __hip_atomic_load(p, __ATOMIC_RELAXED, __HIP_MEMORY_SCOPE_AGENT); }
__device__ __forceinline__ unsigned xb_add(unsigned* p, unsigned v) { return __hip_atomic_fetch_add(p, v, __ATOMIC_RELAXED, __HIP_MEMORY_SCOPE_AGENT); }
__device__ __forceinline__ unsigned xb_xcc_id() { return (unsigned)__builtin_amdgcn_s_getreg((3 << 11) | 20) & 0xFu; }
#define XB_SPIN(cond, bar) do { unsigned _sp = 0; while (cond) { __builtin_amdgcn_s_sleep(1); \
    if ((++_sp & 255u) == 0u) { if (xb_ld(&(bar)[XB_TMO])) break; if (_sp > XB_SPIN_CAP) { atomicAdd(&(bar)[XB_TMO], 1u); break; } } } } while (0)
struct XcdBarrier { unsigned* bar; unsigned x; volatile LAS unsigned* st; };
__device__ __forceinline__ XcdBarrier xcd_barrier_post(unsigned* bar, volatile LAS unsigned* st) {
    XcdBarrier b; b.bar = bar; b.x = xb_xcc_id(); b.st = st;
    if (threadIdx.x == 0) (void)xb_add(&bar[XB_XCNT(b.x)], 1u);
    return b;
}
__device__ __forceinline__ void xcd_barrier_complete(unsigned* bar, unsigned x, unsigned& nloc, unsigned& nx) {
    const unsigned G = gridDim.x * gridDim.y * gridDim.z;
    unsigned sum, cnt, mine, sp = 0u;
    for (;;) {
        sum = 0u; cnt = 0u; mine = 0u;
#pragma unroll
        for (unsigned j = 0; j < 16; ++j) { const unsigned c = xb_ld(&bar[XB_XCNT(j)]); sum += c; cnt += (c > 0u) ? 1u : 0u; mine = (j == x) ? c : mine; }
        if (sum == G) break;
        __builtin_amdgcn_s_sleep(1);
        if ((++sp & 255u) == 0u) { if (xb_ld(&bar[XB_TMO])) break; if (sp > XB_SPIN_CAP) { atomicAdd(&bar[XB_TMO], 1u); break; } }
    }
    nloc = mine > 0u ? mine : 1u; nx = cnt > 0u ? cnt : 1u;
}
__device__ __forceinline__ void xcd_barrier(const XcdBarrier& b) {
    asm volatile("s_waitcnt vmcnt(0)" ::: "memory");
    __syncthreads();
    if (threadIdx.x == 0) {
        unsigned* bar = b.bar;
        __builtin_amdgcn_s_waitcnt(0);
        unsigned nloc = b.st[0], nx = b.st[1];
        if (nloc == 0u) { xcd_barrier_complete(bar, b.x, nloc, nx); b.st[0] = nloc; b.st[1] = nx; }
        const unsigned old = xb_add(&bar[XB_XSUB(b.x)], 1u);
        const unsigned gen = old / nloc;
        if (old + 1u == (gen + 1u) * nloc) {
            __builtin_amdgcn_fence(__ATOMIC_RELEASE, "agent");
            asm volatile("s_waitcnt vmcnt(0)" ::: "memory");
            const unsigned og = xb_add(&bar[XB_TOP], 1u);
            const unsigned tg = og / nx;
            if (og + 1u == (tg + 1u) * nx) xb_add(&bar[XB_TOPGEN], 1u);
            else XB_SPIN(xb_ld(&bar[XB_TOPGEN]) == tg, bar);
            __builtin_amdgcn_fence(__ATOMIC_ACQUIRE, "agent");
            xb_add(&bar[XB_XGEN(b.x)], 1u);
            asm volatile("s_waitcnt vmcnt(0)" ::: "memory");
        } else {
            XB_SPIN(xb_ld(&bar[XB_XGEN(b.x)]) == gen, bar);
            __builtin_amdgcn_fence(__ATOMIC_ACQUIRE, "agent");
            asm volatile("s_waitcnt vmcnt(0)" ::: "memory");
        }
    }
    __syncthreads();
}

__global__ void __launch_bounds__(512, 2) fwd_kernel(Params p) {
    extern __shared__ __attribute__((aligned(16))) unsigned char lds_raw[];
    LAS unsigned char* lds = (LAS unsigned char*)lds_raw;
    cg::grid_group grid = cg::this_grid();
    const int tid = threadIdx.x, lane = tid & 63, wave = __builtin_amdgcn_readfirstlane(tid >> 6);
    const int G = gridDim.x, bx = blockIdx.x;
    const int vcu = (G % 8 == 0) ? (bx % 8) * (G / 8) + bx / 8 : bx;
    const int gw = vcu * 8 + wave, NGW = G * 8;
    unsigned char* ws = p.ws;
    const int lo = p.ph_lo, hi = p.ph_hi;
    volatile LAS unsigned* xbst = (volatile LAS unsigned*)(lds + 131072);
    if (tid < 2) xbst[tid] = 0u;
    __syncthreads();
    XcdBarrier xbar = xcd_barrier_post((unsigned*)ws, xbst);
#ifndef PHMASK
#define PHMASK 0xFFFF
#endif
#define IN(k) (((PHMASK >> (k)) & 1) && lo <= (k) && (k) < hi)
#ifndef REP_PHASE
#define REP_PHASE -1
#endif
#define REPS(k) for (int rep_ = 0; rep_ < ((k) == REP_PHASE ? 2 : 1); ++rep_)
#define SEAM(k) do { if (IN(k) && IN((k) + 1)) { if ((k) == 0) { asm volatile("s_waitcnt vmcnt(0) lgkmcnt(0)" ::: "memory"); __syncthreads(); grid.sync(); } else xcd_barrier(xbar); } } while (0)
    float* XR = p.out;
    bf16_t* XB = (bf16_t*)(ws + WS_XB); bf16_t* ACT = (bf16_t*)(ws + WS_PR); bf16_t* X2B = XB; bf16_t* MIXB = (bf16_t*)(ws + WS_S5);
    float* SLAB = (float*)(ws + WS_SLAB);
    float* ss1 = (float*)(ws + WS_SS1); float* ss2 = (float*)(ws + WS_SS2); float* ss3 = (float*)(ws + WS_SS3); float* ss4 = (float*)(ws + WS_SS4);

    if (IN(0)) REPS(0) phase0(p, lds, gw, NGW, wave, lane);
    SEAM(0);
    if (IN(1)) REPS(1) { pg8::Gemm g{XB, (const bf16_t*)(ws + WS_WGU1), M, 2 * FF, D}; pg8::StaticOrder S; S.init(M, 2 * FF, D, G, bx, 0);
        EpiGU E{ACT, ss1}; pg8::gemm_phase<EpiGU>(lds, g, S, E); }
    SEAM(1);
    if (IN(2)) { pg8::Gemm g{ACT, (const bf16_t*)(ws + WS_WD1), M, D, FF}; pg8::StaticOrder S; S.init(MP, D, FF, G, bx, 11);
        EpiRes E{p.in[0], p.in[1], XR, XB, ss2, 0.5f, SLAB, 4}; pg8::gemm_phase<EpiRes, true>(lds, g, S, E);
        xcd_barrier(xbar); fix_sample_rows(XR, SLAB, 11, 0.5f, ss2, XB, gw, NGW, lane); }
    SEAM(2);
    if (IN(3)) { pg8::Gemm g{XB, (const bf16_t*)(ws + WS_WIN), M, NIN, D}; pg8::StaticOrder S; S.init(M, NIN, D, G, bx, 0);
        EpiIn E{(bf16_t*)(ws + WS_PR), (bf16_t*)(ws + WS_PA), ss2, p.out}; pg8::gemm_phase<EpiIn>(lds, g, S, E); }
    SEAM(3);
    if (IN(4)) {
        prep_load_params(lds, p, tid);
        REPS(4) { for (int ug = vcu; ug < MP / 128; ug += G) prep_unit(lds, p, ug * 8 + wave, lane, tid, 0, 8);
            for (int st = vcu; st < 16; st += G) prep_unit(lds, p, (MP / 128 + (st >> 3)) * 8 + wave, lane, tid, st & 7, (st & 7) + 1); }
        __syncthreads();
        LAS unsigned char* wl = lds + wave * ATT_WL;
        for (int u = gw; u < 8 * 128 * 8 * 2; u += NGW) attn_prompt_unit(wl, (bf16_t*)(ws + WS_PA), p.in[23], u, lane);
        for (int u = gw; u < 16 * 8 * 16; u += NGW) attn_sample_unit(wl, p, u, lane);
    }
    SEAM(4);
    if (IN(5)) REPS(5) {
        for (int u = vcu; u < 256; u += G) { const int bh = u >> 2, vq = u & 3, b = bh >> 3, h = bh & 7;
            scan_unit<32>(lds, p, (size_t)b * SEQ, SEQ, h, vq, nullptr, p.out + O_PWKV + (size_t)bh * 4096, tid); }
        for (int u = vcu; u < 512; u += G) { const int bh = u >> 2, vq = u & 3, sb = bh >> 3, h = bh & 7;
            scan_unit<16>(lds, p, (size_t)MP + sb * 16, 16, h, vq, p.in[3] + (size_t)bh * 4096, p.out + O_SWKV + (size_t)bh * 4096, tid); }
    }
    SEAM(5);
    if (IN(6)) REPS(6) { for (int m = gw; m < M; m += NGW) post_row(p, m, lane); }
    SEAM(6);
    if (IN(7)) { pg8::Gemm g{MIXB, (const bf16_t*)(ws + WS_WOUT), M, D, D}; pg8::StaticOrder S; S.init(MP, D, D, G, bx, 4);
        EpiRes E{XR, XR + (size_t)MP * D, XR, X2B, ss3, 1.0f, SLAB, 4}; pg8::gemm_phase<EpiRes, true>(lds, g, S, E);
        xcd_barrier(xbar); fix_sample_rows(XR, SLAB, 4, 1.0f, ss3, X2B, gw, NGW, lane); }
    SEAM(7);
    if (IN(8)) { pg8::Gemm g{X2B, (const bf16_t*)(ws + WS_WGU2), M, 2 * FF, D}; pg8::StaticOrder S; S.init(M, 2 * FF, D, G, bx, 0);
        EpiGU E{ACT, ss3}; pg8::gemm_phase<EpiGU>(lds, g, S, E); }
    SEAM(8);
    if (IN(9)) { pg8::Gemm g{ACT, (const bf16_t*)(ws + WS_WD2), M, D, FF}; pg8::StaticOrder S; S.init(MP, D, FF, G, bx, 11);
        EpiRes E{XR, XR + (size_t)MP * D, XR, nullptr, nullptr, 0.5f, SLAB, 4}; pg8::gemm_phase<EpiRes, true>(lds, g, S, E);
        xcd_barrier(xbar); fix_sample_rows(XR, SLAB, 11, 0.5f, nullptr, nullptr, gw, NGW, lane); }
    SEAM(9);
    if (IN(10)) {
        const float* nf = p.in[29];
        for (int m = gw; m < M; m += NGW) {
            f32x4* xr = (f32x4*)(XR + (size_t)m * D) + lane;
            f32x4 v[4]; float sq = 0.f;
#pragma unroll
            for (int j = 0; j < 4; ++j) { v[j] = xr[64 * j]; sq += v[j].x * v[j].x + v[j].y * v[j].y + v[j].z * v[j].z + v[j].w * v[j].w; }
            const float rs = rsqrtf(wave_sum(sq) * (1.f / 1024.f) + NORM_EPS);
#pragma unroll
            for (int j = 0; j < 4; ++j) { const f32x4 g4 = *((const f32x4*)nf + 64 * j + lane); xr[64 * j] = v[j] * rs * g4; }
        }
    }
#ifdef DUMP
    if (lo == 13) {
        const bf16_t* MIXd = (const bf16_t*)(ws + WS_S5);
        const float* Yd = (const float*)(ws + WS_PR); const bf16_t* SGd = (const bf16_t*)(ws + WS_G); const bf16_t* SRd = (const bf16_t*)(ws + WS_S5);
        const bf16_t* PAd = (const bf16_t*)(ws + WS_PA);
        for (int m = gw; m < M; m += NGW)
            for (int c = lane; c < D; c += 64) { float v = 0.f;
                if (DUMP == 2 && c < 512) v = bf2f(MIXd[(size_t)m * D + c]);
                if (DUMP == 3 && c >= 512) v = bf2f(MIXd[(size_t)m * D + c]);
                if (DUMP == 4 && c < 512) v = Yd[(size_t)m * RW + c];
                if (DUMP == 5 && c < 512) v = bf2f(SGd[(size_t)m * RW + c]);
                if (DUMP == 6 && c < 512) v = bf2f(SRd[(size_t)m * RW + c]);
                if (DUMP == 7 && c < 512) v = bf2f(PAd[(size_t)m * AC + c]);
                if (DUMP == 8 && c < 128) v = bf2f(((const bf16_t*)(ws + WS_PR))[(size_t)m * RC + 1664 + c]);
                if (DUMP == 9 && c < 128) v = bf2f(((const bf16_t*)(ws + WS_GL))[(size_t)(m & 511) * 128 + c]);
                XR[(size_t)m * D + c] = v; }
    }
#endif
#undef IN
#undef SEAM
}

extern "C" void kernel_launch(void* const* d_in, const int* in_sizes, int n_in, void* d_out, int out_size, void* d_ws, size_t ws_size, hipStream_t stream) {
    static int grid = 0;
    if (grid == 0) {
        if (n_in != 30 || ws_size < WS_END) { fprintf(stderr, "kernel_launch: unexpected n_in %d or ws_size %zu (< %zu)\n", n_in, ws_size, (size_t)WS_END); grid = -1; return; }
        int dev = 0, cus = 0, per_cu = 0;
        (void)hipGetDevice(&dev); (void)hipDeviceGetAttribute(&cus, hipDeviceAttributeMultiprocessorCount, dev);
        if (hipFuncSetAttribute((const void*)fwd_kernel, hipFuncAttributeMaxDynamicSharedMemorySize, LDS_BYTES) != hipSuccess) { fprintf(stderr, "kernel_launch: hipFuncSetAttribute failed\n"); grid = -1; return; }
        if (hipOccupancyMaxActiveBlocksPerMultiprocessor(&per_cu, (const void*)fwd_kernel, 512, LDS_BYTES) != hipSuccess || per_cu < 1) { fprintf(stderr, "kernel_launch: occupancy query failed (%d)\n", per_cu); (void)hipGetLastError(); per_cu = 1; }
        grid = cus * per_cu;
    }
    if (grid < 0) return;
    Params p{};
    for (int i = 0; i < 30; ++i) p.in[i] = (const float*)d_in[i];
    p.out = (float*)d_out; p.ws = (unsigned char*)d_ws;
    (void)hipMemsetAsync(d_ws, 0, XCD_BAR_WORDS * 4, stream);
#ifndef MULTI_LAUNCH
#define MULTI_LAUNCH 0
#endif
#ifndef NPH
#define NPH 11

#endif
#if MULTI_LAUNCH
    for (int k = 0; k < NPH; ++k) { p.ph_lo = k; p.ph_hi = k + 1; hipLaunchKernelGGL(fwd_kernel, dim3(grid), dim3(512), LDS_BYTES, stream, p); }
#ifdef DUMP
    p.ph_lo = 13; p.ph_hi = 14; hipLaunchKernelGGL(fwd_kernel, dim3(grid), dim3(512), LDS_BYTES, stream, p);
#endif
#else
    p.ph_lo = 0; p.ph_hi = 11;
    void* args[] = {&p};
    hipError_t e = hipLaunchCooperativeKernel((const void*)fwd_kernel, dim3(grid), dim3(512), args, LDS_BYTES, stream);
    if (e != hipSuccess) fprintf(stderr, "kernel_launch: cooperative launch failed: %s (grid %d)\n", hipGetErrorString(e), grid);
#endif
}
```

```cpp
#include <hip/hip_runtime.h>


#include <hip/hip_cooperative_groups.h>
#include <cstdio>
namespace cg = cooperative_groups;

#define LAS __attribute__((address_space(3)))
typedef unsigned short bf16_t;
typedef short bf16x8 __attribute__((ext_vector_type(8)));
typedef float f32x4 __attribute__((ext_vector_type(4)));
typedef float f32x2 __attribute__((ext_vector_type(2)));
typedef unsigned u32x4 __attribute__((ext_vector_type(4)));
typedef unsigned u32x2 __attribute__((ext_vector_type(2)));

constexpr int MP = 65536, MS = 256, M = MP + MS, D = 1024, FF = 2816, NIN = 3328, RC = 1792, AC = 1536, RW = 512;
constexpr int SEQ = 8192;
constexpr float NORM_EPS = 1e-5f, GN_EPS = 64e-5f;
constexpr size_t O_YP = 0, O_YS = 67108864, O_PSH = 67371008, O_PWKV = 67385344, O_PK = 67647488, O_PV = 69744640,
                 O_SSH = 71841792, O_SWKV = 71870464, O_SK = 72394752, O_SV = 72525824;
constexpr size_t SSB = (size_t)M * 4;
constexpr size_t WS_SS1 = 65536, WS_SS2 = WS_SS1 + SSB, WS_SS3 = WS_SS2 + SSB, WS_SS4 = WS_SS3 + SSB;
constexpr size_t WS_BON = 2097152;
constexpr size_t WS_W = 5242880;
constexpr size_t WS_WGU1 = WS_W, WS_WD1 = WS_WGU1 + (size_t)2 * FF * D * 2, WS_WIN = WS_WD1 + (size_t)D * FF * 2, WS_WOUT = WS_WIN + (size_t)NIN * D * 2,
                 WS_WGU2 = WS_WOUT + (size_t)D * D * 2, WS_WD2 = WS_WGU2 + (size_t)2 * FF * D * 2, WS_WL = WS_WD2 + (size_t)D * FF * 2,
                 WS_AL = WS_WL + 512 * 64 * 2, WS_GL = WS_AL + 512 * 64 * 2, WS_WEND = WS_GL + 512 * 128 * 2;
constexpr size_t WS_XB = WS_WEND;
constexpr size_t WS_PR = WS_XB + (size_t)M * D * 2;
constexpr size_t WS_PA = WS_PR + (size_t)M * RC * 2;
constexpr size_t WS_S5 = WS_PA + (size_t)M * AC * 2;
constexpr size_t S5B = (size_t)M * RW * 2;
constexpr size_t WS_G = WS_S5 + 5 * S5B;
constexpr size_t WS_INV = WS_G + S5B;
constexpr size_t WS_SLAB = WS_INV + (size_t)M * 8 * 4;
constexpr size_t WS_END = WS_SLAB + (size_t)11 * MS * D * 4;
constexpr int LDS_BYTES = 131072 + 2048;

typedef __bf16 bf16x2_t __attribute__((ext_vector_type(2)));
__device__ __forceinline__ unsigned cvt_pk_bf16(float lo, float hi) { const f32x2 v = {lo, hi}; return __builtin_bit_cast(unsigned, __builtin_convertvector(v, bf16x2_t)); }
__device__ __forceinline__ float bf2f(unsigned short u) { return __builtin_bit_cast(float, (unsigned)u << 16); }
__device__ __forceinline__ float bflo(unsigned u) { return __builtin_bit_cast(float, u << 16); }
__device__ __forceinline__ float bfhi(unsigned u) { return __builtin_bit_cast(float, u & 0xffff0000u); }
__device__ __forceinline__ unsigned short f2bf(float f) { return __builtin_bit_cast(unsigned short, (__bf16)f); }
__device__ __forceinline__ float wave_sum(float v) {
#pragma unroll
    for (int o = 1; o < 64; o <<= 1) v += __shfl_xor(v, o);
    return v;
}
__device__ __forceinline__ float wave_max(float v) {
#pragma unroll
    for (int o = 1; o < 64; o <<= 1) v = fmaxf(v, __shfl_xor(v, o));
    return v;
}
template <int CTRL> __device__ __forceinline__ float dppf(float v) { return __builtin_bit_cast(float, __builtin_amdgcn_mov_dpp(__builtin_bit_cast(int, v), CTRL, 0xF, 0xF, true)); }
__device__ __forceinline__ float row16_sum(float v) { v += dppf<0xB1>(v); v += dppf<0x4E>(v); v += dppf<0x141>(v); v += dppf<0x140>(v); return v; }
__device__ __forceinline__ float row8_sum(float v) { v += dppf<0xB1>(v); v += dppf<0x4E>(v); v += dppf<0x141>(v); return v; }
__device__ __forceinline__ float fast_exp(float x) { return __builtin_amdgcn_exp2f(x * 1.44269504089f); }
__device__ __forceinline__ float sigmoidf_(float x) { return __builtin_amdgcn_rcpf(1.f + fast_exp(-x)); }

__device__ __forceinline__ float xsum_quads(float v) {
    unsigned u = __builtin_bit_cast(unsigned, v);
    auto r = __builtin_amdgcn_permlane16_swap(u, u, false, false);
    v = __builtin_bit_cast(float, (unsigned)r[0]) + __builtin_bit_cast(float, (unsigned)r[1]);
    u = __builtin_bit_cast(unsigned, v);
    auto q = __builtin_amdgcn_permlane32_swap(u, u, false, false);
    return __builtin_bit_cast(float, (unsigned)q[0]) + __builtin_bit_cast(float, (unsigned)q[1]);
}

namespace pg8 {
constexpr int BM = 256, BK = 64, HALF = 128, HTB = HALF * BK * 2, STAGE_BYTES = 8 * HTB, NXCD = 8, WGM = 8;
__host__ __device__ __forceinline__ int lds_byte(int r, int c) { const int st = (r >> 4) * 2 + (c >> 5), rr = r & 15, cc = c & 31, ob = rr * 64 + cc * 2; return st * 1024 + (ob ^ (((ob >> 9) & 1) << 5)); }
__host__ __device__ __forceinline__ void stage_rc(int b, int& R, int& C) { const int st = b / 1024, sb = b % 1024, swz = sb ^ (((sb >> 9) & 1) << 5); R = (st >> 1) * 16 + swz / 64; C = (st & 1) * 32 + (swz % 64) / 2; }
__host__ __device__ __forceinline__ int perm32(int rho) { const int n = rho >> 4, i = rho & 15; return 8 * (i >> 2) + 4 * n + (i & 3); }
struct Unit { int pm, pk;
    __device__ __forceinline__ int pn() const { return pk & 0xff; } __device__ __forceinline__ int kt0() const { return (pk >> 8) & 0xff; }
    __device__ __forceinline__ int nt() const { return (pk >> 16) & 0xff; } __device__ __forceinline__ int slice() const { return pk >> 24; } };
struct Gemm { const bf16_t* A; const bf16_t* Bt; int M, N, K; };
struct StaticOrder {
    int nM, nN, nwg, G, c, ntf, nsl, nts;
    __device__ __forceinline__ void init(int M_, int N_, int K_, int G_, int c_, int nsl_) { nM = M_ / BM; nN = N_ / BM; nwg = nM * nN; G = G_; c = c_; ntf = K_ / BK; nsl = nsl_; nts = nsl_ ? ntf / nsl_ : 0; }
    __device__ __forceinline__ bool next(int i, Unit& u) const {
        const long L = (long)i * G + c;
        if (L >= nwg) {
            const long sidx = L - nwg; if (sidx >= (long)nN * nsl) return false;
            u.pm = nM; u.pk = (int)(sidx % nN) | (((int)(sidx / nN) * nts) << 8) | (nts << 16) | (1 << 24); return true;
        }
        int wgid = (int)L; { const int q = nwg / NXCD, r = nwg % NXCD, xcd = wgid % NXCD, off = wgid / NXCD; wgid = (xcd < r ? xcd * (q + 1) : r * (q + 1) + (xcd - r) * q) + off; }
        const int nig = WGM * nN, gid = wgid / nig, fm = gid * WGM, gsz = (nM - fm) < WGM ? (nM - fm) : WGM;
        u.pm = fm + ((wgid % nig) % gsz); u.pk = ((wgid % nig) / gsz) | (ntf << 16); return true;
    }
};

template <class Epi, bool SLICED = false>
__device__ __forceinline__ void gemm_phase(LAS unsigned char* lds, const Gemm g, const StaticOrder& S, const Epi& E) {
    const int tid = threadIdx.x, wid = __builtin_amdgcn_readfirstlane(tid >> 6), lane = tid & 63, wr = wid >> 2, wc = wid & 3, fr = lane & 15, fq = lane >> 4;
    const int K = g.K;
    unsigned voffA[2], voffB[2];
#pragma unroll
    for (int i = 0; i < 2; ++i) { int R, C; stage_rc(tid * 16 + i * 8192, R, C); const int Rb = Epi::PERM ? ((R & ~31) + perm32(R & 31)) : R;
        voffA[i] = (unsigned)(R * K + C) * 2u; voffB[i] = (unsigned)(Rb * K + C) * 2u; }
    const size_t kstep = (size_t)(BK * 2);
    const size_t hstep = (size_t)HALF * K * 2;
    const size_t tstep = 2 * hstep;
    const unsigned ldsw = (unsigned)wid * 1024u;
    const int aoff = lds_byte(wr * 64 + fr, fq * 8), boff = lds_byte(wc * 32 + fr, fq * 8);
#define PG8_SA(b, h) (((b) * 2 + (h)) * HTB)
#define PG8_SB(b, h) ((4 + (b) * 2 + (h)) * HTB)
#define PG8_STAGE(bufoff, gbase, voff) do { _Pragma("unroll") for (int _i = 0; _i < 2; ++_i) \
        __builtin_amdgcn_global_load_lds((const unsigned*)((const char*)(gbase) + (voff)[_i]), (LAS unsigned*)(lds + (bufoff) + ldsw + _i * 8192), 16, 0, 0); } while (0)
#define PG8_LDA(dst, b, h) do { _Pragma("unroll") for (int m = 0; m < 4; ++m) _Pragma("unroll") for (int k = 0; k < 2; ++k) dst[m][k] = *(const LAS bf16x8*)(lds + PG8_SA(b, h) + aoff + m * 2048 + k * 1024); } while (0)
#define PG8_LDB(dst, b, h) do { _Pragma("unroll") for (int n = 0; n < 2; ++n) _Pragma("unroll") for (int k = 0; k < 2; ++k) dst[n][k] = *(const LAS bf16x8*)(lds + PG8_SB(b, h) + boff + n * 2048 + k * 1024); } while (0)
#define PG8_MMA(ai, bj, At, Bt) do { __builtin_amdgcn_s_setprio(1); _Pragma("unroll") for (int m = 0; m < 4; ++m) _Pragma("unroll") for (int n = 0; n < 2; ++n) _Pragma("unroll") for (int k = 0; k < 2; ++k) \
        acc[ai][bj][m][n] = __builtin_amdgcn_mfma_f32_16x16x32_bf16(Bt[n][k], At[m][k], acc[ai][bj][m][n], 0, 0, 0); __builtin_amdgcn_s_setprio(0); } while (0)
#define PG8_WAIT_V(n) asm volatile("s_waitcnt vmcnt(" #n ")" ::: "memory")
#define PG8_WAIT_L(n) asm volatile("s_waitcnt lgkmcnt(" #n ")" ::: "memory")
#define PG8_BAR __builtin_amdgcn_s_barrier()
#define PG8_SCHED __builtin_amdgcn_sched_barrier(0)
    Unit cur, nxt; int ui = 0;
    if (!S.next(0, cur)) return;
    f32x4 acc[2][2][4][2];
#pragma unroll
    for (int a = 0; a < 2; ++a)
#pragma unroll
        for (int b = 0; b < 2; ++b)
#pragma unroll
            for (int m = 0; m < 4; ++m)
#pragma unroll
                for (int n = 0; n < 2; ++n) acc[a][b][m][n] = (f32x4){0.f, 0.f, 0.f, 0.f};
    bf16x8 At[4][2], B0[2][2], B1[2][2];
    typename Epi::Pre pre = E.prefetch(cur, wr, fr);
    const char* cA = (const char*)g.A + (size_t)cur.pm * tstep + (SLICED ? (size_t)cur.kt0() * kstep : 0); const char* cB = (const char*)g.Bt + (size_t)cur.pn() * tstep + (SLICED ? (size_t)cur.kt0() * kstep : 0);
    PG8_STAGE(PG8_SB(0, 0), cB, voffB); PG8_STAGE(PG8_SA(0, 0), cA, voffA); PG8_STAGE(PG8_SB(0, 1), cB + hstep, voffB); PG8_STAGE(PG8_SA(0, 1), cA + hstep, voffA);
    if (wr == 1) PG8_BAR;
    PG8_WAIT_V(4); PG8_BAR;
    PG8_STAGE(PG8_SB(1, 0), cB + kstep, voffB); PG8_STAGE(PG8_SA(1, 0), cA + kstep, voffA); PG8_STAGE(PG8_SB(1, 1), cB + hstep + kstep, voffB);
    PG8_WAIT_V(6); PG8_BAR;
    for (;;) {
        const bool has_next = S.next(ui + 1, nxt);
        const char* nA = has_next ? (const char*)g.A + (size_t)nxt.pm * tstep + (SLICED ? (size_t)nxt.kt0() * kstep : 0) : cA; const char* nB = has_next ? (const char*)g.Bt + (size_t)nxt.pn() * tstep + (SLICED ? (size_t)nxt.kt0() * kstep : 0) : cB;
        const int nt = SLICED ? cur.nt() : K / BK;
        for (int t = 0; t < nt; t += 2) {
            const bool last = (t == nt - 2);
            const char* a1 = cA + (size_t)(t + 1) * kstep;
            const char* a2 = last ? nA : cA + (size_t)(t + 2) * kstep; const char* b2 = last ? nB : cB + (size_t)(t + 2) * kstep;
            const char* a3 = a2 + kstep; const char* b3 = b2 + kstep;
            PG8_LDB(B0, 0, 0); PG8_SCHED; PG8_LDA(At, 0, 0); PG8_STAGE(PG8_SA(1, 1), a1 + hstep, voffA);
            PG8_WAIT_L(8); PG8_BAR; PG8_WAIT_L(0); PG8_MMA(0, 0, At, B0); PG8_BAR; PG8_SCHED;
            PG8_LDB(B1, 0, 1); PG8_STAGE(PG8_SB(0, 0), b2, voffB);
            PG8_BAR; PG8_WAIT_L(0); PG8_MMA(0, 1, At, B1); PG8_BAR;
            PG8_LDA(At, 0, 1); PG8_STAGE(PG8_SA(0, 0), a2, voffA);
            PG8_BAR; PG8_WAIT_L(0); PG8_MMA(1, 0, At, B0); PG8_BAR; PG8_SCHED;
            PG8_STAGE(PG8_SB(0, 1), b2 + hstep, voffB);
            PG8_WAIT_V(6); PG8_BAR; PG8_MMA(1, 1, At, B1); PG8_BAR;
            PG8_LDB(B0, 1, 0); PG8_SCHED; PG8_LDA(At, 1, 0); PG8_STAGE(PG8_SA(0, 1), a2 + hstep, voffA);
            PG8_WAIT_L(8); PG8_BAR; PG8_WAIT_L(0); PG8_MMA(0, 0, At, B0); PG8_BAR; PG8_SCHED;
            PG8_LDB(B1, 1, 1); PG8_STAGE(PG8_SB(1, 0), b3, voffB);
            PG8_BAR; PG8_WAIT_L(0); PG8_MMA(0, 1, At, B1); PG8_BAR;
            PG8_LDA(At, 1, 1); PG8_STAGE(PG8_SA(1, 0), a3, voffA);
            PG8_BAR; PG8_WAIT_L(0); PG8_MMA(1, 0, At, B0); PG8_BAR; PG8_SCHED;
            PG8_STAGE(PG8_SB(1, 1), b3 + hstep, voffB);
            PG8_WAIT_V(6); PG8_BAR; PG8_MMA(1, 1, At, B1); PG8_BAR;
        }
        E(acc, cur, wr, wc, fr, fq, pre);
        if (!has_next) break;
        pre = E.prefetch(nxt, wr, fr);
#pragma unroll
        for (int a = 0; a < 2; ++a)
#pragma unroll
            for (int b = 0; b < 2; ++b)
#pragma unroll
                for (int m = 0; m < 4; ++m)
#pragma unroll
                    for (int n = 0; n < 2; ++n) acc[a][b][m][n] = (f32x4){0.f, 0.f, 0.f, 0.f};
        cur = nxt; cA = nA; cB = nB; ++ui;
    }
    PG8_WAIT_V(0);
    if (wr == 0) PG8_BAR;
    PG8_BAR;
#undef PG8_SA
#undef PG8_SB
#undef PG8_STAGE
#undef PG8_LDA
#undef PG8_LDB
#undef PG8_MMA
#undef PG8_WAIT_V
#undef PG8_WAIT_L
#undef PG8_BAR
#undef PG8_SCHED
}
}

struct EpiGU {
    static constexpr bool PERM = true;
    bf16_t* O; const float* ss;
    struct Pre { float s[8]; };
    __device__ __forceinline__ Pre prefetch(const pg8::Unit& u, int wr, int fr) const { Pre q; const int row0 = u.pm * 256 + wr * 64 + fr;
#pragma unroll
        for (int i = 0; i < 8; ++i) q.s[i] = ss[row0 + (i >> 2) * 128 + (i & 3) * 16];
        return q; }
    __device__ __forceinline__ void operator()(const f32x4 (&acc)[2][2][4][2], const pg8::Unit& u, int wr, int wc, int fr, int fq, const Pre& pre) const {
        const int row0 = u.pm * 256 + wr * 64 + fr, col0 = u.pn() * 128 + wc * 32 + 8 * fq;
#pragma unroll
        for (int ai = 0; ai < 2; ++ai)
#pragma unroll
            for (int m = 0; m < 4; ++m) {
                const int row = row0 + ai * 128 + m * 16;
                const float rs = rsqrtf(pre.s[ai * 4 + m] * (1.f / 1024.f) + NORM_EPS);
                f32x4 ov[2];
#pragma unroll
                for (int n = 0; n < 2; ++n) {
                    const f32x4 g4 = acc[ai][0][m][n] * rs, u4 = acc[ai][1][m][n] * rs;
                    const f32x4 t4 = g4 * (-1.44269504089f);
                    f32x4 e4; e4.x = __builtin_amdgcn_exp2f(t4.x); e4.y = __builtin_amdgcn_exp2f(t4.y); e4.z = __builtin_amdgcn_exp2f(t4.z); e4.w = __builtin_amdgcn_exp2f(t4.w);
                    const f32x4 d4 = e4 + 1.0f;
                    f32x4 r4; r4.x = __builtin_amdgcn_rcpf(d4.x); r4.y = __builtin_amdgcn_rcpf(d4.y); r4.z = __builtin_amdgcn_rcpf(d4.z); r4.w = __builtin_amdgcn_rcpf(d4.w);
                    ov[n] = (g4 * u4) * r4;
                }
                u32x4 w; w.x = cvt_pk_bf16(ov[0].x, ov[0].y); w.y = cvt_pk_bf16(ov[0].z, ov[0].w); w.z = cvt_pk_bf16(ov[1].x, ov[1].y); w.w = cvt_pk_bf16(ov[1].z, ov[1].w);
                *(u32x4*)(O + (size_t)row * FF + col0) = w;
            }
    }
};
struct EpiRes {
    static constexpr bool PERM = true;
    const float* resP; const float* resS; float* XR; bf16_t* XBo; float* ssn; float scale; float* slab; int nts;
    struct Pre {};
    __device__ __forceinline__ Pre prefetch(const pg8::Unit&, int, int) const { return Pre{}; }
    __device__ __forceinline__ void operator()(const f32x4 (&acc)[2][2][4][2], const pg8::Unit& u, int wr, int wc, int fr, int fq, const Pre&) const {
        const int row0 = u.pm * 256 + wr * 64 + fr, col0 = u.pn() * 256 + wc * 32 + 8 * fq;
        if (u.slice()) {
            float* sl = slab + (size_t)(u.kt0() / nts) * (MS * D) + (size_t)(row0 - MP) * D + col0;
#pragma unroll
            for (int ai = 0; ai < 2; ++ai)
#pragma unroll
                for (int m = 0; m < 4; ++m)
#pragma unroll
                    for (int bj = 0; bj < 2; ++bj) { float* q = sl + (size_t)(ai * 128 + m * 16) * D + bj * 128;
                        *(f32x4*)q = acc[ai][bj][m][0]; *(f32x4*)(q + 4) = acc[ai][bj][m][1]; }
            return;
        }
        f32x4 q0[2], q1[2];
#pragma unroll
        for (int it = 0; it < 2; ++it) { const int row = row0 + (it >> 3) * 128 + ((it >> 1) & 3) * 16;
            const float* rp = (row < MP ? resP + (size_t)row * D : resS + (size_t)(row - MP) * D) + col0 + (it & 1) * 128;
            q0[it] = *(const f32x4*)rp; q1[it] = *(const f32x4*)(rp + 4); }
        float sq = 0.f;
#pragma unroll
        for (int it = 0; it < 16; ++it) {
            const int ai = it >> 3, m = (it >> 1) & 3, bj = it & 1;
            const int row = row0 + ai * 128 + m * 16, c = col0 + bj * 128;
            const f32x4 r0 = q0[it & 1], r1 = q1[it & 1];
            if (it + 2 < 16) { const int it2 = it + 2; const int row2 = row0 + (it2 >> 3) * 128 + ((it2 >> 1) & 3) * 16;
                const float* rp = (row2 < MP ? resP + (size_t)row2 * D : resS + (size_t)(row2 - MP) * D) + col0 + (it2 & 1) * 128;
                q0[it & 1] = *(const f32x4*)rp; q1[it & 1] = *(const f32x4*)(rp + 4); }
            const f32x4 v0 = r0 + scale * acc[ai][bj][m][0], v1 = r1 + scale * acc[ai][bj][m][1];
            *(f32x4*)(XR + (size_t)row * D + c) = v0; *(f32x4*)(XR + (size_t)row * D + c + 4) = v1;
            sq += v0.x * v0.x + v0.y * v0.y + v0.z * v0.z + v0.w * v0.w + v1.x * v1.x + v1.y * v1.y + v1.z * v1.z + v1.w * v1.w;
            if (XBo) { u32x4 w; w.x = cvt_pk_bf16(v0.x, v0.y); w.y = cvt_pk_bf16(v0.z, v0.w); w.z = cvt_pk_bf16(v1.x, v1.y); w.w = cvt_pk_bf16(v1.z, v1.w);
                *(u32x4*)(XBo + (size_t)row * D + c) = w; }
            if (bj == 1) { if (ssn) { const float tot = xsum_quads(sq); if (fq == 0) atomicAdd(ssn + row, tot); } sq = 0.f; }
        }
    }
};
struct EpiIn {
    static constexpr bool PERM = true;
    bf16_t* PR; bf16_t* PA; const float* ss; float* out;
    struct Pre { float s[8]; };
    __device__ __forceinline__ Pre prefetch(const pg8::Unit& u, int wr, int fr) const { Pre q; const int row0 = u.pm * 256 + wr * 64 + fr;
#pragma unroll
        for (int i = 0; i < 8; ++i) q.s[i] = ss[row0 + (i >> 2) * 128 + (i & 3) * 16];
        return q; }
    __device__ __forceinline__ void operator()(const f32x4 (&acc)[2][2][4][2], const pg8::Unit& u, int wr, int wc, int fr, int fq, const Pre& pre) const {
        const int row0 = u.pm * 256 + wr * 64 + fr, col0 = u.pn() * 256 + wc * 32 + 8 * fq;
        const int pn = u.pn();
#pragma unroll
        for (int ai = 0; ai < 2; ++ai)
#pragma unroll
            for (int m = 0; m < 4; ++m) {
                const int row = row0 + ai * 128 + m * 16;
                const float rs = rsqrtf(pre.s[ai * 4 + m] * (1.f / 1024.f) + NORM_EPS);
#pragma unroll
                for (int bj = 0; bj < 2; ++bj) {
                    const int c = col0 + bj * 128;
                    const f32x4 v0 = acc[ai][bj][m][0] * rs, v1 = acc[ai][bj][m][1] * rs;
                    u32x4 w; w.x = cvt_pk_bf16(v0.x, v0.y); w.y = cvt_pk_bf16(v0.z, v0.w); w.z = cvt_pk_bf16(v1.x, v1.y); w.w = cvt_pk_bf16(v1.z, v1.w);
                    float* fo = nullptr;
                    if (pn < 7) {
                        *(u32x4*)(PR + (size_t)row * RC + c) = w;
                        if (row < MP) { if ((row & (SEQ - 1)) == SEQ - 1) fo = out + O_PSH + (size_t)(row >> 13) * RC + c; }
                        else { const int r = row - MP; if ((r & 15) == 15) fo = out + O_SSH + (size_t)(r >> 4) * RC + c; }
                    } else {
                        const int ca = c - RC;
                        *(u32x4*)(PA + (size_t)row * AC + ca) = w;
                        if (pn >= 9) {
                            const int cc = ca - 512, isv = cc >> 9, c2 = cc & 511, h = c2 >> 6, d = c2 & 63;
                            if (row < MP) { const int t = row & (SEQ - 1), b = row >> 13;
                                if (t >= SEQ - 512) fo = out + (isv ? O_PV : O_PK) + ((size_t)(b * 8 + h) * 512 + (t - (SEQ - 512))) * 64 + d; }
                            else { const int r = row - MP, sb = r >> 4, st = r & 15;
                                fo = out + (isv ? O_SV : O_SK) + ((size_t)(sb * 8 + h) * 16 + st) * 64 + d; }
                        }
                    }
                    if (fo) { *(f32x4*)fo = v0; *(f32x4*)(fo + 4) = v1; }
                }
            }
    }
};

__device__ __forceinline__ void tr_item(const float* W, int K, int N, bf16_t* WT, const float* scale, int mode, LAS float* scr, int item, int lane) {
    const int nblk = N / 32, kb = item / nblk, nb = item % nblk, k0 = 64 * kb, n0 = 32 * nb;
#pragma unroll 8
    for (int i = 0; i < 32; ++i) { const int kk = 2 * i + (lane >> 5); float v = W[(size_t)(k0 + kk) * N + n0 + (lane & 31)]; if (scale) v *= scale[k0 + kk]; scr[kk * 33 + (lane & 31)] = v; }
    asm volatile("s_waitcnt lgkmcnt(0)" ::: "memory");
    const int c = lane & 7;
#pragma unroll
    for (int j = 0; j < 4; ++j) { const int n = (lane >> 3) + 8 * j; const LAS float* s = scr + (8 * c) * 33 + n;
        u32x4 o; o.x = cvt_pk_bf16(s[0 * 33], s[1 * 33]); o.y = cvt_pk_bf16(s[2 * 33], s[3 * 33]); o.z = cvt_pk_bf16(s[4 * 33], s[5 * 33]); o.w = cvt_pk_bf16(s[6 * 33], s[7 * 33]);
        const int ng = n0 + n; const int rr = mode == 0 ? ng : (((ng >> 7) << 8) + (ng & 127) + (mode == 2 ? 128 : 0));
        *(u32x4*)(WT + (size_t)rr * K + k0 + 8 * c) = o; }
    asm volatile("s_waitcnt lgkmcnt(0)" ::: "memory");
}

struct Params { const float* in[30]; float* out; unsigned char* ws; int ph_lo, ph_hi; };

__device__ __forceinline__ void phase0(const Params& p, LAS unsigned char* lds, int gw, int NGW, int wave, int lane) {
    unsigned char* ws = p.ws;
    LAS float* scr = (LAS float*)(lds + wave * 8448);
    constexpr int I_GU = (D / 64) * (FF / 32), I_DN = (FF / 64) * (D / 32), I_IN = (D / 64) * (NIN / 32), I_OUT = (D / 64) * (D / 32), I_L = 16, I_GL = 32;
    constexpr int NITEMS = 4 * I_GU + 2 * I_DN + I_IN + I_OUT + 2 * I_L + I_GL;
    for (int it = gw; it < NITEMS; it += NGW) {
        int r = it;
        if (r < I_GU) { tr_item(p.in[7], D, FF, (bf16_t*)(ws + WS_WGU1), p.in[6], 1, scr, r, lane); continue; } r -= I_GU;
        if (r < I_GU) { tr_item(p.in[8], D, FF, (bf16_t*)(ws + WS_WGU1), p.in[6], 2, scr, r, lane); continue; } r -= I_GU;
        if (r < I_DN) { tr_item(p.in[9], FF, D, (bf16_t*)(ws + WS_WD1), nullptr, 0, scr, r, lane); continue; } r -= I_DN;
        if (r < I_IN) { tr_item(p.in[11], D, NIN, (bf16_t*)(ws + WS_WIN), p.in[10], 0, scr, r, lane); continue; } r -= I_IN;
        if (r < I_OUT) { tr_item(p.in[24], D, D, (bf16_t*)(ws + WS_WOUT), nullptr, 0, scr, r, lane); continue; } r -= I_OUT;
        if (r < I_GU) { tr_item(p.in[26], D, FF, (bf16_t*)(ws + WS_WGU2), p.in[25], 1, scr, r, lane); continue; } r -= I_GU;
        if (r < I_GU) { tr_item(p.in[27], D, FF, (bf16_t*)(ws + WS_WGU2), p.in[25], 2, scr, r, lane); continue; } r -= I_GU;
        if (r < I_DN) { tr_item(p.in[28], FF, D, (bf16_t*)(ws + WS_WD2), nullptr, 0, scr, r, lane); continue; } r -= I_DN;
        if (r < I_L) { tr_item(p.in[14], 64, 512, (bf16_t*)(ws + WS_WL), nullptr, 0, scr, r, lane); continue; } r -= I_L;
        if (r < I_L) { tr_item(p.in[16], 64, 512, (bf16_t*)(ws + WS_AL), nullptr, 0, scr, r, lane); continue; } r -= I_L;
        tr_item(p.in[17], 128, 512, (bf16_t*)(ws + WS_GL), nullptr, 0, scr, r, lane);
    }
    bf16_t* XB = (bf16_t*)(ws + WS_XB);
    float* SLAB = (float*)(ws + WS_SLAB);
    float* ss1 = (float*)(ws + WS_SS1);
    for (int m = gw; m < M; m += NGW) {
        const float* xrow = m < MP ? p.in[0] + (size_t)m * D : p.in[1] + (size_t)(m - MP) * D;
        const f32x4* xr = (const f32x4*)xrow + lane;
        f32x4 v[4]; float s = 0.f;
#pragma unroll
        for (int j = 0; j < 4; ++j) { v[j] = xr[64 * j]; s += v[j].x * v[j].x + v[j].y * v[j].y + v[j].z * v[j].z + v[j].w * v[j].w; }
        s = wave_sum(s);
        if (lane == 0) ss1[m] = s;
        if (m >= MP) { f32x4* xo = (f32x4*)(p.out + (size_t)m * D) + lane;
#pragma unroll
            for (int j = 0; j < 4; ++j) xo[64 * j] = v[j]; }
        u32x2* o8 = (u32x2*)(XB + (size_t)m * D) + lane;
#pragma unroll
        for (int j = 0; j < 4; ++j) { u32x2 o; o.x = cvt_pk_bf16(v[j].x, v[j].y); o.y = cvt_pk_bf16(v[j].z, v[j].w); o8[64 * j] = o; }
    }
    float* ssz = (float*)(ws + WS_SS2);
    for (int i = gw * 64 + lane; i < 3 * M; i += NGW * 64) ssz[i] = 0.f;
}

__device__ __forceinline__ float ld_prev(const bf16_t* PR, const float* sshift, int row, int col) {
    if (row < MP) { if ((row & (SEQ - 1)) == 0) return 0.f; return bf2f(PR[(size_t)(row - 1) * RC + col]); }
    const int r = row - MP; if ((r & 15) == 0) return sshift[(size_t)(r >> 4) * RC + col];
    return bf2f(PR[(size_t)(row - 1) * RC + col]);
}
__device__ __forceinline__ void up8(const u32x4 u, float (&f)[8]) { f[0] = bflo(u.x); f[1] = bfhi(u.x); f[2] = bflo(u.y); f[3] = bfhi(u.y); f[4] = bflo(u.z); f[5] = bfhi(u.z); f[6] = bflo(u.w); f[7] = bfhi(u.w); }
__device__ __forceinline__ void ld8f(const float* p, float (&f)[8]) { const f32x4 a = *(const f32x4*)p, b = *(const f32x4*)(p + 4); f[0] = a.x; f[1] = a.y; f[2] = a.z; f[3] = a.w; f[4] = b.x; f[5] = b.y; f[6] = b.z; f[7] = b.w; }
__device__ __forceinline__ u32x4 pk8(const float (&o)[8]) { u32x4 w; w.x = cvt_pk_bf16(o[0], o[1]); w.y = cvt_pk_bf16(o[2], o[3]); w.z = cvt_pk_bf16(o[4], o[5]); w.w = cvt_pk_bf16(o[6], o[7]); return w; }
constexpr int LW_PITCH = 144, LG_PITCH = 272, LW_OFF = 0, LA_OFF = 64 * LW_PITCH, LGL_OFF = 2 * 64 * LW_PITCH;
constexpr int PT_OFF = 36864;
constexpr int PT_MU = 0, PT_W0 = 1792, PT_A0 = 2304, PT_KK = 2816, PT_KA = 3328, PT_RK = 3840, PT_N = 4352;
__device__ __forceinline__ void prep_load_params(LAS unsigned char* lds, const Params& p, int tid) {
    LAS float* PT = (LAS float*)(lds + PT_OFF);
    for (int i = tid; i < PT_N; i += 512) {
        float v;
        if (i < PT_W0) v = p.in[12][i]; else if (i < PT_A0) v = p.in[13][i - PT_W0]; else if (i < PT_KK) v = p.in[15][i - PT_A0];
        else if (i < PT_KA) v = p.in[18][i - PT_KK]; else if (i < PT_RK) v = p.in[19][i - PT_KA]; else v = p.in[20][i - PT_RK];
        PT[i] = v;
    }
    __syncthreads();
}
__device__ __forceinline__ void lds8f(const LAS float* q, float (&f)[8]) { const f32x4 a = *(const LAS f32x4*)q, b = *(const LAS f32x4*)(q + 4); f[0] = a.x; f[1] = a.y; f[2] = a.z; f[3] = a.w; f[4] = b.x; f[5] = b.y; f[6] = b.z; f[7] = b.w; }
__device__ __forceinline__ void prep_unit(LAS unsigned char* lds, const Params& p, int u, int lane, int tid, int h_lo, int h_hi) {
    unsigned char* ws = p.ws;
    const bf16_t* PR = (const bf16_t*)(ws + WS_PR);
    const float* sshift = p.in[2];
    const LAS float* PT = (const LAS float*)(lds + PT_OFF);
    const bf16_t* WL = (const bf16_t*)(ws + WS_WL); const bf16_t* AL = (const bf16_t*)(ws + WS_AL); const bf16_t* GL = (const bf16_t*)(ws + WS_GL);
    float* SW = (float*)(ws + WS_XB);
    bf16_t* SR = (bf16_t*)(ws + WS_S5); bf16_t* SK = (bf16_t*)(ws + WS_S5 + S5B); bf16_t* SV = (bf16_t*)(ws + WS_S5 + 2 * S5B);
    bf16_t* SKK = (bf16_t*)(ws + WS_S5 + 3 * S5B); bf16_t* SB = (bf16_t*)(ws + WS_S5 + 4 * S5B); bf16_t* SG = (bf16_t*)(ws + WS_G);
    float* BON = (float*)(ws + WS_BON);
    const int row0 = u * 16, i16 = lane & 15, quad = lane >> 4;
    const int row = row0 + i16;
    const bool zero_prev = row < MP && (row & (SEQ - 1)) == 0;
    const bool st_prev = row >= MP && ((row - MP) & 15) == 0;
    const bf16_t* prow = PR + (size_t)row * RC;
    const bf16_t* pprev = PR + (size_t)(zero_prev || st_prev ? row : row - 1) * RC;
    const float* sprev = sshift + (size_t)(st_prev ? ((row - MP) >> 4) : 0) * RC;
    auto lerp8 = [&](const u32x4 cu, const u32x4 pu, int col, float (&x)[8]) {
        float cf[8], pf[8], mf[8];
        up8(cu, cf);
        if (st_prev) ld8f(sprev + col, pf); else up8(pu, pf);
        lds8f(PT + PT_MU + col, mf);
#pragma unroll
        for (int j = 0; j < 8; ++j) { const float pv = zero_prev ? 0.f : pf[j]; x[j] = cf[j] + (pv - cf[j]) * mf[j]; }
    };
    bf16x8 Bf[8];
    {
        u32x4 cu[8], pu[8];
#pragma unroll
        for (int s8 = 0; s8 < 8; ++s8) { const int col = 1536 + s8 * 32 + quad * 8; cu[s8] = *(const u32x4*)(prow + col); pu[s8] = *(const u32x4*)(pprev + col); }
#pragma unroll
        for (int s8 = 0; s8 < 8; ++s8) {
            float xv[8]; lerp8(cu[s8], pu[s8], 1536 + s8 * 32 + quad * 8, xv);
#pragma unroll
            for (int j = 0; j < 8; ++j) {
                if (s8 < 2) xv[j] = 1.f - 2.f * __builtin_amdgcn_rcpf(1.f + fast_exp(2.f * xv[j]));
                else if (s8 >= 4) xv[j] = sigmoidf_(xv[j]);
            }
            Bf[s8] = __builtin_bit_cast(bf16x8, pk8(xv));
        }
    }
#pragma unroll 1
    for (int h = h_lo; h < h_hi; ++h) {
        { const int r = tid >> 3, ch = tid & 7;
          const u32x4 gwl = *(const u32x4*)(WL + (size_t)(h * 64 + r) * 64 + ch * 8), gal = *(const u32x4*)(AL + (size_t)(h * 64 + r) * 64 + ch * 8);
          u32x4 ggl[2];
#pragma unroll
          for (int i = 0; i < 2; ++i) { const int pz = tid + 512 * i, rr = pz >> 4, c2 = pz & 15; ggl[i] = *(const u32x4*)(GL + (size_t)(h * 64 + rr) * 128 + c2 * 8); }
          __syncthreads();
          *(LAS u32x4*)(lds + LW_OFF + r * LW_PITCH + ch * 16) = gwl;
          *(LAS u32x4*)(lds + LA_OFF + r * LW_PITCH + ch * 16) = gal;
#pragma unroll
          for (int i = 0; i < 2; ++i) { const int pz = tid + 512 * i, rr = pz >> 4, c2 = pz & 15; *(LAS u32x4*)(lds + LGL_OFF + rr * LG_PITCH + c2 * 16) = ggl[i]; } }
        __syncthreads();
        float ssq = 0.f, bs = 0.f;
#pragma unroll 1
        for (int g2 = 0; g2 < 2; ++g2) {
            const int cbase = h * 64 + g2 * 32;
            const int c0 = cbase + 8 * quad;
            const size_t o = (size_t)row * RW + c0;
            const u32x4 rcu = *(const u32x4*)(prow + c0), kcu = *(const u32x4*)(prow + 512 + c0), vcu = *(const u32x4*)(prow + 1024 + c0);
            const u32x4 rpu = *(const u32x4*)(pprev + c0), kpu = *(const u32x4*)(pprev + 512 + c0), vpu = *(const u32x4*)(pprev + 1024 + c0);
            f32x4 aW[2], aA[2], aG[2];
#pragma unroll
            for (int t = 0; t < 2; ++t) {
                const int rl = g2 * 32 + 8 * (i16 >> 2) + 4 * t + (i16 & 3);
                aW[t] = (f32x4){0.f, 0.f, 0.f, 0.f}; aA[t] = aW[t]; aG[t] = aW[t];
#pragma unroll
                for (int ks = 0; ks < 2; ++ks) {
                    const bf16x8 fw = *(const LAS bf16x8*)(lds + LW_OFF + rl * LW_PITCH + (ks * 32 + quad * 8) * 2);
                    const bf16x8 fa = *(const LAS bf16x8*)(lds + LA_OFF + rl * LW_PITCH + (ks * 32 + quad * 8) * 2);
                    aW[t] = __builtin_amdgcn_mfma_f32_16x16x32_bf16(fw, Bf[ks], aW[t], 0, 0, 0);
                    aA[t] = __builtin_amdgcn_mfma_f32_16x16x32_bf16(fa, Bf[2 + ks], aA[t], 0, 0, 0);
                }
#pragma unroll
                for (int ks = 0; ks < 4; ++ks) {
                    const bf16x8 fg = *(const LAS bf16x8*)(lds + LGL_OFF + rl * LG_PITCH + (ks * 32 + quad * 8) * 2);
                    aG[t] = __builtin_amdgcn_mfma_f32_16x16x32_bf16(fg, Bf[4 + ks], aG[t], 0, 0, 0);
                }
            }
            float gg[8], dec[8], av[8], k4[8], kru[8], kbu[8], rs[8], vs[8];
#pragma unroll
            for (int e = 0; e < 8; ++e) gg[e] = aG[e >> 2][e & 3];
            { float w0v[8]; lds8f(PT + PT_W0 + c0, w0v);
#pragma unroll
              for (int e = 0; e < 8; ++e) { const float z = -(w0v[e] + aW[e >> 2][e & 3]);
                  const float sp = fmaxf(z, 0.f) + __logf(1.f + fast_exp(-fabsf(z)));
                  dec[e] = fast_exp(-fast_exp(-sp - 0.5f)); } }
            { float a0v[8]; lds8f(PT + PT_A0 + c0, a0v);
#pragma unroll
              for (int e = 0; e < 8; ++e) av[e] = sigmoidf_(a0v[e] + aA[e >> 2][e & 3]); }
            { float ks_[8], kkv[8], kav[8]; lerp8(kcu, kpu, 512 + c0, ks_); lds8f(PT + PT_KK + c0, kkv); lds8f(PT + PT_KA + c0, kav);
#pragma unroll
              for (int e = 0; e < 8; ++e) { const float kr = ks_[e] * kkv[e]; kru[e] = kr; kbu[e] = kr * av[e]; ssq += kr * kr; k4[e] = ks_[e] * (1.f + (av[e] - 1.f) * kav[e]); } }
            { float rkv[8]; lerp8(rcu, rpu, c0, rs); lds8f(PT + PT_RK + c0, rkv);
#pragma unroll
              for (int e = 0; e < 8; ++e) bs += rs[e] * k4[e] * rkv[e]; }
            lerp8(vcu, vpu, 1024 + c0, vs);
            *(u32x4*)(SG + o) = pk8(gg);
            *(f32x4*)(SW + o) = (f32x4){dec[0], dec[1], dec[2], dec[3]}; *(f32x4*)(SW + o + 4) = (f32x4){dec[4], dec[5], dec[6], dec[7]};
            *(u32x4*)(SK + o) = pk8(k4); *(u32x4*)(SKK + o) = pk8(kru); *(u32x4*)(SB + o) = pk8(kbu);
            *(u32x4*)(SR + o) = pk8(rs); *(u32x4*)(SV + o) = pk8(vs);
        }
        ssq += __shfl_xor(ssq, 16); ssq += __shfl_xor(ssq, 32);
        bs += __shfl_xor(bs, 16); bs += __shfl_xor(bs, 32);
        if (quad == 0) { BON[(size_t)row * 8 + h] = bs; ((float*)(ws + WS_INV))[(size_t)row * 8 + h] = rsqrtf(fmaxf(ssq, 1e-24f)); }
    }
}

__device__ __forceinline__ bf16x8 tr_read2(unsigned a0, unsigned a1) {
    u32x2 r0, r1;
    asm volatile("ds_read_b64_tr_b16 %0, %2\n\tds_read_b64_tr_b16 %1, %3\n\ts_waitcnt lgkmcnt(0)" : "=&v"(r0), "=&v"(r1) : "v"(a0), "v"(a1) : "memory");
    u32x4 w; w.x = r0.x; w.y = r0.y; w.z = r1.x; w.w = r1.y;
    return __builtin_bit_cast(bf16x8, w);
}
__device__ __forceinline__ void tr_read8(unsigned a, bf16x8 (&Av)[4]) {
    u32x2 r0, r1, r2, r3, r4, r5, r6, r7;
    asm volatile("ds_read_b64_tr_b16 %0, %8\n\tds_read_b64_tr_b16 %1, %8 offset:2304\n\t"
                 "ds_read_b64_tr_b16 %2, %8 offset:32\n\tds_read_b64_tr_b16 %3, %8 offset:2336\n\t"
                 "ds_read_b64_tr_b16 %4, %8 offset:64\n\tds_read_b64_tr_b16 %5, %8 offset:2368\n\t"
                 "ds_read_b64_tr_b16 %6, %8 offset:96\n\tds_read_b64_tr_b16 %7, %8 offset:2400\n\ts_waitcnt lgkmcnt(0)"
                 : "=&v"(r0), "=&v"(r1), "=&v"(r2), "=&v"(r3), "=&v"(r4), "=&v"(r5), "=&v"(r6), "=&v"(r7) : "v"(a) : "memory");
    u32x4 w;
    w.x = r0.x; w.y = r0.y; w.z = r1.x; w.w = r1.y; Av[0] = __builtin_bit_cast(bf16x8, w);
    w.x = r2.x; w.y = r2.y; w.z = r3.x; w.w = r3.y; Av[1] = __builtin_bit_cast(bf16x8, w);
    w.x = r4.x; w.y = r4.y; w.z = r5.x; w.w = r5.y; Av[2] = __builtin_bit_cast(bf16x8, w);
    w.x = r6.x; w.y = r6.y; w.z = r7.x; w.w = r7.y; Av[3] = __builtin_bit_cast(bf16x8, w);
}
constexpr int ATT_WL = 10496, VPITCH = 144;
constexpr int QT = 2;
__device__ __forceinline__ void attn_prompt_unit(LAS unsigned char* wl, bf16_t* PA, const float* relb, int u, int lane) {
    const int h = u & 7, qh = (u >> 3) & 1, cb = u >> 4, c = cb & 127, b = cb >> 7;
    const int i16 = lane & 15, quad = lane >> 4;
    const size_t c0 = (size_t)b * SEQ + (size_t)c * 64;
    const size_t q0 = c0 + qh * 32;
    LAS float* tab = (LAS float*)(wl + 9216);
    for (int i = lane; i < 257; i += 64) tab[i] = relb[h * 257 + i] * 1.44269504089f;
    const float tab0 = relb[h * 257] * 1.44269504089f;
    bf16x8 Bq[QT][2];
#pragma unroll
    for (int qt = 0; qt < QT; ++qt)
#pragma unroll
        for (int ks = 0; ks < 2; ++ks) Bq[qt][ks] = *(const bf16x8*)(PA + (q0 + qt * 16 + i16) * AC + h * 64 + ks * 32 + quad * 8);
    f32x4 O[4][QT];
    float mrun[QT], lrun[QT];
#pragma unroll
    for (int qt = 0; qt < QT; ++qt) { mrun[qt] = -1e30f; lrun[qt] = 0.f;
#pragma unroll
        for (int dt = 0; dt < 4; ++dt) O[dt][qt] = (f32x4){0.f, 0.f, 0.f, 0.f}; }
    const unsigned wbase = (unsigned)(unsigned long)wl;
    const int kt0 = (c < 8 ? 8 - c : 0);
    bf16x8 Kc[4][2]; u32x4 Vc[8];
    auto issue_tile = [&](int kt, bf16x8 (&Kx)[4][2], u32x4 (&Vx)[8]) {
        const size_t k0 = c0 - (size_t)(8 - kt) * 64;
#pragma unroll
        for (int kti = 0; kti < 4; ++kti) { const bf16_t* kp = PA + (k0 + kti * 16 + i16) * AC + 512 + h * 64 + quad * 8;
            Kx[kti][0] = *(const bf16x8*)kp; Kx[kti][1] = *(const bf16x8*)(kp + 32); }
#pragma unroll
        for (int i = 0; i < 8; ++i) { const int pz = lane + 64 * i, key = pz >> 3, ch = pz & 7;
            Vx[i] = *(const u32x4*)(PA + (k0 + key) * AC + 1024 + h * 64 + ch * 8); }
    };
    issue_tile(kt0, Kc, Vc);
    for (int kt = kt0; kt <= 8; ++kt) {
#pragma unroll
        for (int i = 0; i < 8; ++i) { const int pz = lane + 64 * i, key = pz >> 3, ch = pz & 7; *(LAS u32x4*)(wl + key * VPITCH + ch * 16) = Vc[i]; }
        bf16x8 Ku[4][2];
#pragma unroll
        for (int kti = 0; kti < 4; ++kti) { Ku[kti][0] = Kc[kti][0]; Ku[kti][1] = Kc[kti][1]; }
        if (kt < 8) issue_tile(kt + 1, Kc, Vc);
        f32x4 St[4][QT];
#pragma unroll
        for (int kti = 0; kti < 4; ++kti) {
#pragma unroll
            for (int qt = 0; qt < QT; ++qt) {
                f32x4 s = {0.f, 0.f, 0.f, 0.f};
                s = __builtin_amdgcn_mfma_f32_16x16x32_bf16(Ku[kti][0], Bq[qt][0], s, 0, 0, 0);
                s = __builtin_amdgcn_mfma_f32_16x16x32_bf16(Ku[kti][1], Bq[qt][1], s, 0, 0, 0);
                St[kti][qt] = s;
            }
        }
        const float sc = 0.125f * 1.44269504089f;
        if (kt < 6) {
#pragma unroll
            for (int kti = 0; kti < 4; ++kti)
#pragma unroll
                for (int qt = 0; qt < QT; ++qt) St[kti][qt] = St[kti][qt] * sc + tab0;
        } else {
#pragma unroll
            for (int kti = 0; kti < 4; ++kti)
#pragma unroll
                for (int qt = 0; qt < QT; ++qt)
#pragma unroll
                    for (int j = 0; j < 4; ++j) {
                        int rel = (kt - 8) * 64 + kti * 16 + quad * 4 + j - (qh * 32 + qt * 16 + i16);
                        rel = rel < -128 ? -128 : (rel > 128 ? 128 : rel);
                        St[kti][qt][j] = St[kti][qt][j] * sc + tab[rel + 128];
                    }
        }
#pragma unroll
        for (int qt = 0; qt < QT; ++qt) {
            float mx = -1e30f;
#pragma unroll
            for (int kti = 0; kti < 4; ++kti)
#pragma unroll
                for (int j = 0; j < 4; ++j) mx = fmaxf(mx, St[kti][qt][j]);
            mx = fmaxf(mx, __shfl_xor(mx, 16)); mx = fmaxf(mx, __shfl_xor(mx, 32));
            const float mnew = fmaxf(mrun[qt], mx);
            const float alpha = __builtin_amdgcn_exp2f(mrun[qt] - mnew);
            mrun[qt] = mnew;
            float ps = 0.f;
#pragma unroll
            for (int kti = 0; kti < 4; ++kti)
#pragma unroll
                for (int j = 0; j < 4; ++j) { const float pv = __builtin_amdgcn_exp2f(St[kti][qt][j] - mnew); St[kti][qt][j] = pv; ps += pv; }
            lrun[qt] = lrun[qt] * alpha + ps;
#pragma unroll
            for (int dt = 0; dt < 4; ++dt) O[dt][qt] = O[dt][qt] * alpha;
        }
#pragma unroll
        for (int ks2 = 0; ks2 < 2; ++ks2) {
            bf16x8 Bp[QT];
#pragma unroll
            for (int qt = 0; qt < QT; ++qt) {
                u32x4 w; const f32x4 p0 = St[2 * ks2][qt], p1 = St[2 * ks2 + 1][qt];
                w.x = cvt_pk_bf16(p0.x, p0.y); w.y = cvt_pk_bf16(p0.z, p0.w); w.z = cvt_pk_bf16(p1.x, p1.y); w.w = cvt_pk_bf16(p1.z, p1.w);
                Bp[qt] = __builtin_bit_cast(bf16x8, w);
            }
            bf16x8 Av[4];
            tr_read8(wbase + (unsigned)((32 * ks2 + 4 * quad + (i16 >> 2)) * VPITCH + (4 * (lane & 3)) * 2), Av);
#pragma unroll
            for (int dt = 0; dt < 4; ++dt)
#pragma unroll
                for (int qt = 0; qt < QT; ++qt) O[dt][qt] = __builtin_amdgcn_mfma_f32_16x16x32_bf16(Av[dt], Bp[qt], O[dt][qt], 0, 0, 0);
        }
    }
#pragma unroll
    for (int qt = 0; qt < QT; ++qt) {
        float l = lrun[qt]; l += __shfl_xor(l, 16); l += __shfl_xor(l, 32);
        const float inv = 1.f / l;
#pragma unroll
        for (int dt = 0; dt < 4; ++dt) {
            const f32x4 o = O[dt][qt] * inv;
            u32x2 w; w.x = cvt_pk_bf16(o.x, o.y); w.y = cvt_pk_bf16(o.z, o.w);
            *(u32x2*)(PA + (q0 + qt * 16 + i16) * AC + h * 64 + dt * 16 + quad * 4) = w;
        }
    }
}
__device__ __forceinline__ void attn_sample_unit(LAS unsigned char* wl, const Params& p, int u, int lane) {
    bf16_t* PA = (bf16_t*)(p.ws + WS_PA);
    const int i = u & 15, h = (u >> 4) & 7, sb = u >> 7;
    const size_t qrow = (size_t)MP + sb * 16 + i;
    LAS float* qs = (LAS float*)wl; LAS float* pb = (LAS float*)(wl + 256);
    qs[lane] = bf2f(PA[qrow * AC + h * 64 + lane]);
    const float* ck = p.in[4] + (size_t)(sb * 8 + h) * 512 * 64; const float* cv = p.in[5] + (size_t)(sb * 8 + h) * 512 * 64;
    const float* nk = p.out + O_SK + (size_t)(sb * 8 + h) * 16 * 64; const float* nv = p.out + O_SV + (size_t)(sb * 8 + h) * 16 * 64;
    const float* tabg = p.in[23] + h * 257;
    float mx = -1e30f;
#pragma unroll 1
    for (int ps = 0; ps < 9; ++ps) {
        const int j = ps * 64 + lane;
        if (j < 528) {
            const float* kr = j < 512 ? ck + (size_t)j * 64 : nk + (size_t)(j - 512) * 64;
            float a = 0.f;
#pragma unroll
            for (int d = 0; d < 64; d += 4) { const f32x4 kv = *(const f32x4*)(kr + d); const f32x4 qv = *(const LAS f32x4*)(qs + d); a += kv.x * qv.x + kv.y * qv.y + kv.z * qv.z + kv.w * qv.w; }
            int rel = j - 512 - i; rel = rel < -128 ? -128 : (rel > 128 ? 128 : rel);
            const float s = a * 0.125f + tabg[rel + 128];
            pb[j] = s; mx = fmaxf(mx, s);
        }
    }
    mx = wave_max(mx);
    float sum = 0.f;
#pragma unroll 1
    for (int ps = 0; ps < 9; ++ps) { const int j = ps * 64 + lane; if (j < 528) { const float e = fast_exp(pb[j] - mx); sum += e; pb[j] = e; } }
    sum = wave_sum(sum);
    float o = 0.f;
    float o1 = 0.f, o2 = 0.f, o3 = 0.f;
#pragma unroll 8
    for (int j = 0; j < 512; j += 4) { o += pb[j] * cv[(size_t)j * 64 + lane]; o1 += pb[j + 1] * cv[(size_t)(j + 1) * 64 + lane]; o2 += pb[j + 2] * cv[(size_t)(j + 2) * 64 + lane]; o3 += pb[j + 3] * cv[(size_t)(j + 3) * 64 + lane]; }
#pragma unroll
    for (int j = 0; j < 16; ++j) o += pb[512 + j] * nv[(size_t)j * 64 + lane];
    o += o1 + o2 + o3;
    PA[qrow * AC + h * 64 + lane] = f2bf(o / sum);
}

constexpr int STEP_B = 1344;
template <int NS>
__device__ __forceinline__ void scan_unit(LAS unsigned char* lds, const Params& p, size_t row0, int T, int h, int vq, const float* s_init, float* s_out, int tid) {
    unsigned char* ws = p.ws;
    const float* SW = (const float*)(ws + WS_XB);
    const bf16_t* SR = (const bf16_t*)(ws + WS_S5); const bf16_t* SK = (const bf16_t*)(ws + WS_S5 + S5B); const bf16_t* SV = (const bf16_t*)(ws + WS_S5 + 2 * S5B);
    const bf16_t* SKK = (const bf16_t*)(ws + WS_S5 + 3 * S5B); const bf16_t* SB = (const bf16_t*)(ws + WS_S5 + 4 * S5B);
    float* Y = (float*)(ws + WS_PR);
    constexpr int BUF_B = NS * STEP_B;
    LAS unsigned char* ybase = lds + 2 * 32 * STEP_B;
    const int nchunks = T / NS;
    const bool loader = tid >= 256;
    const int L = tid - 256;
    const int lane = tid & 63, wv = tid >> 6, vi = lane >> 4, kj = lane & 15, rloc = wv * 4 + vi;
    f32x2 S01 = {0.f, 0.f}, S23 = {0.f, 0.f};
    if (!loader && s_init) { const f32x4 s = *(const f32x4*)(s_init + (size_t)(vq * 16 + rloc) * 64 + 4 * kj); S01 = (f32x2){s.x, s.y}; S23 = (f32x2){s.z, s.w}; }
    f32x4 gw_[(NS * 16 + 255) / 256]; u32x4 gkk = {0u, 0u, 0u, 0u}, gb = gkk, gk = gkk, gr = gkk, gv = gkk; float ginv = 0.f;
    const float* INV = (const float*)(ws + WS_INV);
#pragma unroll
    for (int i = 0; i < (NS * 16 + 255) / 256; ++i) gw_[i] = (f32x4){0.f, 0.f, 0.f, 0.f};
    auto issue_chunk = [&](int c) {
        const size_t r0 = row0 + (size_t)c * NS;
#pragma unroll
        for (int i = 0; i < (NS * 16 + 255) / 256; ++i) { const int pz = L + 256 * i; if (pz < NS * 16) { const int st = pz >> 4, o = pz & 15;
            gw_[i] = *(const f32x4*)(SW + (r0 + st) * RW + h * 64 + o * 4); } }
        if (L < NS * 8) { const int st = L >> 3, o = L & 7; const size_t g = (r0 + st) * RW + h * 64 + o * 8;
            gkk = *(const u32x4*)(SKK + g); gb = *(const u32x4*)(SB + g); gk = *(const u32x4*)(SK + g); gr = *(const u32x4*)(SR + g); ginv = INV[(r0 + st) * 8 + h]; }
        if (L < NS * 2) { const int st = L >> 1, hf = L & 1; gv = *(const u32x4*)(SV + (r0 + st) * RW + h * 64 + vq * 16 + hf * 8); }
    };
    auto commit_chunk = [&](int c) {
        LAS unsigned char* buf = lds + (c & 1) * 32 * STEP_B;
#pragma unroll
        for (int i = 0; i < (NS * 16 + 255) / 256; ++i) { const int pz = L + 256 * i; if (pz < NS * 16) { const int st = pz >> 4, o = pz & 15;
            *(LAS f32x4*)(buf + st * STEP_B + o * 16) = gw_[i]; } }
        if (L < NS * 8) { const int st = L >> 3, o = L & 7;
            const u32x4 a = gkk, b = gb, k = gk, r = gr;
            LAS unsigned char* d = buf + st * STEP_B + o * 32;
            *(LAS f32x4*)(d + 256) = (f32x4){bflo(a.x), bfhi(a.x), bflo(a.y), bfhi(a.y)} * ginv; *(LAS f32x4*)(d + 256 + 16) = (f32x4){bflo(a.z), bfhi(a.z), bflo(a.w), bfhi(a.w)} * ginv;
            *(LAS f32x4*)(d + 512) = (f32x4){bflo(b.x), bfhi(b.x), bflo(b.y), bfhi(b.y)} * ginv; *(LAS f32x4*)(d + 512 + 16) = (f32x4){bflo(b.z), bfhi(b.z), bflo(b.w), bfhi(b.w)} * ginv;
            *(LAS f32x4*)(d + 768) = (f32x4){bflo(k.x), bfhi(k.x), bflo(k.y), bfhi(k.y)}; *(LAS f32x4*)(d + 768 + 16) = (f32x4){bflo(k.z), bfhi(k.z), bflo(k.w), bfhi(k.w)};
            *(LAS f32x4*)(d + 1024) = (f32x4){bflo(r.x), bfhi(r.x), bflo(r.y), bfhi(r.y)}; *(LAS f32x4*)(d + 1024 + 16) = (f32x4){bflo(r.z), bfhi(r.z), bflo(r.w), bfhi(r.w)}; }
        if (L < NS * 2) { const int st = L >> 1, hf = L & 1; const u32x4 v = gv;
            LAS unsigned char* d = buf + st * STEP_B + 1280 + hf * 32;
            *(LAS f32x4*)d = (f32x4){bflo(v.x), bfhi(v.x), bflo(v.y), bfhi(v.y)}; *(LAS f32x4*)(d + 16) = (f32x4){bflo(v.z), bfhi(v.z), bflo(v.w), bfhi(v.w)}; }
    };
    auto flush_y = [&](int c) {
        if (L < NS * 4) { const int st = L >> 2, q = L & 3; const f32x4 v = *(const LAS f32x4*)(ybase + (c & 1) * 2048 + st * 64 + q * 16);
            *(f32x4*)(Y + (row0 + (size_t)c * NS + st) * RW + h * 64 + vq * 16 + q * 4) = v; }
    };
#define SCAN_BAR() do { asm volatile("s_waitcnt lgkmcnt(0)" ::: "memory"); __builtin_amdgcn_s_barrier(); asm volatile("" ::: "memory"); } while (0)
    if (loader) { issue_chunk(0); commit_chunk(0); if (nchunks > 1) issue_chunk(1); }
    SCAN_BAR();
    for (int c = 0; c < nchunks; ++c) {
        if (loader) {
            if (c + 1 < nchunks) commit_chunk(c + 1);
            if (c + 2 < nchunks) issue_chunk(c + 2);
            if (c > 0) flush_y(c - 1);
        } else {
            LAS unsigned char* buf = lds + (c & 1) * 32 * STEP_B;
            LAS float* yb = (LAS float*)(ybase + (c & 1) * 2048);
            f32x4 w4 = *(const LAS f32x4*)(buf + kj * 16), kk4 = *(const LAS f32x4*)(buf + 256 + kj * 16), b4 = *(const LAS f32x4*)(buf + 512 + kj * 16),
                  k4 = *(const LAS f32x4*)(buf + 768 + kj * 16), r4 = *(const LAS f32x4*)(buf + 1024 + kj * 16);
            float vv = *(const LAS float*)(buf + 1280 + rloc * 4);
            float ykeep = 0.f, ypart = 0.f;
#pragma unroll
            for (int s = 0; s <= NS; ++s) {
                f32x4 w4n = w4, kk4n = kk4, b4n = b4, k4n = k4, r4n = r4; float vvn = vv;
                if (s + 1 < NS) { LAS unsigned char* sp = buf + (s + 1) * STEP_B;
                    w4n = *(const LAS f32x4*)(sp + kj * 16); kk4n = *(const LAS f32x4*)(sp + 256 + kj * 16); b4n = *(const LAS f32x4*)(sp + 512 + kj * 16);
                    k4n = *(const LAS f32x4*)(sp + 768 + kj * 16); r4n = *(const LAS f32x4*)(sp + 1024 + kj * 16); vvn = *(const LAS float*)(sp + 1280 + rloc * 4); }
                float sa = 0.f;
                if (s < NS) { f32x2 t = S01 * (f32x2){kk4.x, kk4.y}; t = S23 * (f32x2){kk4.z, kk4.w} + t; sa = t.x + t.y; }
                float yr = ypart;
                sa += dppf<0xB1>(sa); yr += dppf<0xB1>(yr);
                sa += dppf<0x4E>(sa); yr += dppf<0x4E>(yr);
                sa += dppf<0x141>(sa); yr += dppf<0x141>(yr);
                sa += dppf<0x140>(sa); yr += dppf<0x140>(yr);
                if (s > 0) { ykeep = (kj == ((s - 1) & 15)) ? yr : ykeep;
                    if (((s - 1) & 15) == 15) yb[((s - 1) - 15 + kj) * 16 + rloc] = ykeep; }
                if (s < NS) {
                    const f32x2 vk01 = (f32x2){vv, vv} * (f32x2){k4.x, k4.y}, vk23 = (f32x2){vv, vv} * (f32x2){k4.z, k4.w};
                    S01 = S01 * (f32x2){w4.x, w4.y} + vk01; S23 = S23 * (f32x2){w4.z, w4.w} + vk23;
                    const f32x2 nsa = {-sa, -sa};
                    S01 = nsa * (f32x2){b4.x, b4.y} + S01; S23 = nsa * (f32x2){b4.z, b4.w} + S23;
                    f32x2 yy = S01 * (f32x2){r4.x, r4.y}; yy = S23 * (f32x2){r4.z, r4.w} + yy;
                    ypart = yy.x + yy.y;
                }
                w4 = w4n; kk4 = kk4n; b4 = b4n; k4 = k4n; r4 = r4n; vv = vvn;
            }
        }
        SCAN_BAR();
    }
    if (loader) flush_y(nchunks - 1);
    else *(f32x4*)(s_out + (size_t)(vq * 16 + rloc) * 64 + 4 * kj) = (f32x4){S01.x, S01.y, S23.x, S23.y};
    SCAN_BAR();
#undef SCAN_BAR
}

__device__ __forceinline__ void post_row(const Params& p, int row, int lane) {
    unsigned char* ws = p.ws;
    const float* Y = (const float*)(ws + WS_PR); const bf16_t* PA = (const bf16_t*)(ws + WS_PA); const bf16_t* SV = (const bf16_t*)(ws + WS_S5 + 2 * S5B);
    const bf16_t* SG = (const bf16_t*)(ws + WS_G); const float* BON = (const float*)(ws + WS_BON); bf16_t* MIX = (bf16_t*)(ws + WS_S5);
    const int c0 = lane * 8, h = lane >> 3;
    const f32x4 y0 = *(const f32x4*)(Y + (size_t)row * RW + c0), y1 = *(const f32x4*)(Y + (size_t)row * RW + c0 + 4);
    float yv[8] = {y0.x, y0.y, y0.z, y0.w, y1.x, y1.y, y1.z, y1.w};
    float s = 0.f;
#pragma unroll
    for (int j = 0; j < 8; ++j) s += yv[j];
    const float mean = row8_sum(s) * (1.f / 64.f);
    float s2 = 0.f;
#pragma unroll
    for (int j = 0; j < 8; ++j) { yv[j] -= mean; s2 += yv[j] * yv[j]; }
    const float rstd = rsqrtf(row8_sum(s2) * (1.f / 64.f) + GN_EPS);
    const u32x4 vu = *(const u32x4*)(SV + (size_t)row * RW + c0), gu = *(const u32x4*)(SG + (size_t)row * RW + c0);
    const float vf[8] = {bflo(vu.x), bfhi(vu.x), bflo(vu.y), bfhi(vu.y), bflo(vu.z), bfhi(vu.z), bflo(vu.w), bfhi(vu.w)};
    const float gf[8] = {bflo(gu.x), bfhi(gu.x), bflo(gu.y), bfhi(gu.y), bflo(gu.z), bfhi(gu.z), bflo(gu.w), bfhi(gu.w)};
    const float bd = BON[(size_t)row * 8 + h];
    const float* lw = p.in[21] + c0; const float* lb = p.in[22] + c0;
    float o[8];
#pragma unroll
    for (int j = 0; j < 8; ++j) o[j] = (yv[j] * rstd * lw[j] + lb[j] + bd * vf[j]) * gf[j];
    u32x4 w; w.x = cvt_pk_bf16(o[0], o[1]); w.y = cvt_pk_bf16(o[2], o[3]); w.z = cvt_pk_bf16(o[4], o[5]); w.w = cvt_pk_bf16(o[6], o[7]);
    *(u32x4*)(MIX + (size_t)row * D + c0) = w;
    *(u32x4*)(MIX + (size_t)row * D + 512 + c0) = *(const u32x4*)(PA + (size_t)row * AC + c0);
}


__device__ __forceinline__ void rowss_phase(const float* XR, float* ss, int gw, int NGW, int lane) {
    for (int m = gw; m < M; m += NGW) {
        const f32x4* xr = (const f32x4*)(XR + (size_t)m * D) + lane; float s = 0.f;
#pragma unroll
        for (int j = 0; j < 4; ++j) { const f32x4 v = xr[64 * j]; s += v.x * v.x + v.y * v.y + v.z * v.z + v.w * v.w; }
        s = wave_sum(s);
        if (lane == 0) ss[m] = s;
    }
}

__device__ __forceinline__ void fix_sample_rows(float* XR, const float* slab, int nsl, float scale, float* ssn, bf16_t* XBo, int gw, int NGW, int lane) {
    for (int m = MP + gw; m < M; m += NGW) {
        f32x4* xr = (f32x4*)(XR + (size_t)m * D) + lane; f32x4 v[4], a[4]; float s = 0.f;
#pragma unroll
        for (int j = 0; j < 4; ++j) { v[j] = xr[64 * j]; a[j] = (f32x4){0.f, 0.f, 0.f, 0.f}; }
        for (int q = 0; q < nsl; ++q) { const f32x4* sp = (const f32x4*)(slab + (size_t)q * (MS * D) + (size_t)(m - MP) * D) + lane;
#pragma unroll
            for (int j = 0; j < 4; ++j) a[j] += sp[64 * j]; }
#pragma unroll
        for (int j = 0; j < 4; ++j) { v[j] += scale * a[j]; xr[64 * j] = v[j]; s += v[j].x * v[j].x + v[j].y * v[j].y + v[j].z * v[j].z + v[j].w * v[j].w; }
        s = wave_sum(s);
        if (ssn && lane == 0) ssn[m] = s;
        if (XBo) { u32x2* o8 = (u32x2*)(XBo + (size_t)m * D) + lane;
#pragma unroll
            for (int j = 0; j < 4; ++j) { u32x2 o; o.x = cvt_pk_bf16(v[j].x, v[j].y); o.y = cvt_pk_bf16(v[j].z, v[j].w); o8[64 * j] = o; } }
    }
}

#define XB_TMO      128
#define XB_XCNT(j)  (256  + 64 * (j))
#define XB_XSUB(j)  (1280 + 64 * (j))
#define XB_XGEN(j)  (2304 + 64 * (j))
#define XB_TOP      3328
#define XB_TOPGEN   3392
#define XCD_BAR_WORDS 3456
#define XB_SPIN_CAP (1u << 22)
__device__ __forceinline__ unsigned xb_ld(unsigned* p)              { return __hip_atomic_load(p, __ATOMIC_RELAXED, __HIP_MEMORY_SCOPE_AGENT); }
__device__ __forceinline__ unsigned xb_add(unsigned* p, unsigned v) { return __hip_atomic_fetch_add(p, v, __ATOMIC_RELAXED, __HIP_MEMORY_SCOPE_AGENT); }
__device__ __forceinline__ unsigned xb_xcc_id() { return (unsigned)__builtin_amdgcn_s_getreg((3 << 11) | 20) & 0xFu; }
#define XB_SPIN(cond, bar) do { unsigned _sp = 0; while (cond) { __builtin_amdgcn_s_sleep(1); \
    if ((++_sp & 255u) == 0u) { if (xb_ld(&(bar)[XB_TMO])) break; if (_sp > XB_SPIN_CAP) { atomicAdd(&(bar)[XB_TMO], 1u); break; } } } } while (0)
struct XcdBarrier { unsigned* bar; unsigned x; volatile LAS unsigned* st; };
__device__ __forceinline__ XcdBarrier xcd_barrier_post(unsigned* bar, volatile LAS unsigned* st) {
    XcdBarrier b; b.bar = bar; b.x = xb_xcc_id(); b.st = st;
    if (threadIdx.x == 0) (void)xb_add(&bar[XB_XCNT(b.x)], 1u);
    return b;
}
__device__ __forceinline__ void xcd_barrier_complete(unsigned* bar, unsigned x, unsigned& nloc, unsigned& nx) {
    const unsigned G = gridDim.x * gridDim.y * gridDim.z;
    unsigned sum, cnt, mine, sp = 0u;
    for (;;) {
        sum = 0u; cnt = 0u; mine = 0u;
#pragma unroll
        for (unsigned j = 0; j < 16; ++j) { const unsigned c = xb_ld(&bar[XB_XCNT(j)]); sum += c; cnt += (c > 0u) ? 1u : 0u; mine = (j == x) ? c : mine; }
        if (sum == G) break;
        __builtin_amdgcn_s_sleep(1);
        if ((++sp & 255u) == 0u) { if (xb_ld(&bar[XB_TMO])) break; if (sp > XB_SPIN_CAP) { atomicAdd(&bar[XB_TMO], 1u); break; } }
    }
    nloc = mine > 0u ? mine : 1u; nx = cnt > 0u ? cnt : 1u;
}
__device__ __forceinline__ void xcd_barrier(const XcdBarrier& b) {
    asm volatile("s_waitcnt vmcnt(0)" ::: "memory");
    __syncthreads();
    if (threadIdx.x == 0) {
        unsigned* bar = b.bar;
        __builtin_amdgcn_s_waitcnt(0);
        unsigned nloc = b.st[0], nx = b.st[1];
        if (nloc == 0u) { xcd_barrier_complete(bar, b.x, nloc, nx); b.st[0] = nloc; b.st[1] = nx; }
        const unsigned old = xb_add(&bar[XB_XSUB(b.x)], 1u);
        const unsigned gen = old / nloc;
        if (old + 1u == (gen + 1u) * nloc) {
            __builtin_amdgcn_fence(__ATOMIC_RELEASE, "agent");
            asm volatile("s_waitcnt vmcnt(0)" ::: "memory");
            const unsigned og = xb_add(&bar[XB_TOP], 1u);
            const unsigned tg = og / nx;
            if (og + 1u == (tg + 1u) * nx) xb_add(&bar[XB_TOPGEN], 1u);
            else XB_SPIN(xb_ld(&bar[XB_TOPGEN]) == tg, bar);
            __builtin_amdgcn_fence(__ATOMIC_ACQUIRE, "agent");
            xb_add(&bar[XB_XGEN(b.x)], 1u);
            asm volatile("s_waitcnt vmcnt(0)" ::: "memory");
        } else {
            XB_SPIN(xb_ld(&bar[XB_XGEN(b.x)]) == gen, bar);
            __builtin_amdgcn_fence(__ATOMIC_ACQUIRE, "agent");
            asm volatile("s_waitcnt vmcnt(0)" ::: "memory");
        }
    }
    __syncthreads();
}

__global__ void __launch_bounds__(512, 2) fwd_kernel(Params p) {
    extern __shared__ __attribute__((aligned(16))) unsigned char lds_raw[];
    LAS unsigned char* lds = (LAS unsigned char*)lds_raw;
    cg::grid_group grid = cg::this_grid();
    const int tid = threadIdx.x, lane = tid & 63, wave = __builtin_amdgcn_readfirstlane(tid >> 6);
    const int G = gridDim.x, bx = blockIdx.x;
    const int vcu = (G % 8 == 0) ? (bx % 8) * (G / 8) + bx / 8 : bx;
    const int gw = vcu * 8 + wave, NGW = G * 8;
    unsigned char* ws = p.ws;
    const int lo = p.ph_lo, hi = p.ph_hi;
    volatile LAS unsigned* xbst = (volatile LAS unsigned*)(lds + 131072);
    if (tid < 2) xbst[tid] = 0u;
    __syncthreads();
    XcdBarrier xbar = xcd_barrier_post((unsigned*)ws, xbst);
#ifndef PHMASK
#define PHMASK 0xFFFF
#endif
#define IN(k) (((PHMASK >> (k)) & 1) && lo <= (k) && (k) < hi)
#ifndef REP_PHASE
#define REP_PHASE -1
#endif
#define REPS(k) for (int rep_ = 0; rep_ < ((k) == REP_PHASE ? 2 : 1); ++rep_)
#define SEAM(k) do { if (IN(k) && IN((k) + 1)) { if (lo < 0) { asm volatile("s_waitcnt vmcnt(0) lgkmcnt(0)" ::: "memory"); __syncthreads(); grid.sync(); } else xcd_barrier(xbar); } } while (0)
    float* XR = p.out;
    bf16_t* XB = (bf16_t*)(ws + WS_XB); bf16_t* ACT = (bf16_t*)(ws + WS_PR); bf16_t* X2B = XB; bf16_t* MIXB = (bf16_t*)(ws + WS_S5);
    float* SLAB = (float*)(ws + WS_SLAB);
    float* ss1 = (float*)(ws + WS_SS1); float* ss2 = (float*)(ws + WS_SS2); float* ss3 = (float*)(ws + WS_SS3); float* ss4 = (float*)(ws + WS_SS4);

    if (IN(0)) REPS(0) phase0(p, lds, gw, NGW, wave, lane);
    SEAM(0);
    if (IN(1)) REPS(1) { pg8::Gemm g{XB, (const bf16_t*)(ws + WS_WGU1), M, 2 * FF, D}; pg8::StaticOrder S; S.init(M, 2 * FF, D, G, bx, 0);
        EpiGU E{ACT, ss1}; pg8::gemm_phase<EpiGU>(lds, g, S, E); }
    SEAM(1);
    if (IN(2)) { pg8::Gemm g{ACT, (const bf16_t*)(ws + WS_WD1), M, D, FF}; pg8::StaticOrder S; S.init(MP, D, FF, G, bx, 11);
        EpiRes E{p.in[0], p.in[1], XR, XB, ss2, 0.5f, SLAB, 4}; pg8::gemm_phase<EpiRes, true>(lds, g, S, E);
        xcd_barrier(xbar); fix_sample_rows(XR, SLAB, 11, 0.5f, ss2, XB, gw, NGW, lane); }
    SEAM(2);
    if (IN(3)) { pg8::Gemm g{XB, (const bf16_t*)(ws + WS_WIN), M, NIN, D}; pg8::StaticOrder S; S.init(M, NIN, D, G, bx, 0);
        EpiIn E{(bf16_t*)(ws + WS_PR), (bf16_t*)(ws + WS_PA), ss2, p.out}; pg8::gemm_phase<EpiIn>(lds, g, S, E); }
    SEAM(3);
    if (IN(4)) {
        prep_load_params(lds, p, tid);
        REPS(4) { for (int ug = vcu; ug < MP / 128; ug += G) prep_unit(lds, p, ug * 8 + wave, lane, tid, 0, 8);
            for (int st = vcu; st < 16; st += G) prep_unit(lds, p, (MP / 128 + (st >> 3)) * 8 + wave, lane, tid, st & 7, (st & 7) + 1); }
        __syncthreads();
        LAS unsigned char* wl = lds + wave * ATT_WL;
        for (int u = gw; u < 8 * 128 * 8 * 2; u += NGW) attn_prompt_unit(wl, (bf16_t*)(ws + WS_PA), p.in[23], u, lane);
        for (int u = gw; u < 16 * 8 * 16; u += NGW) attn_sample_unit(wl, p, u, lane);
    }
    SEAM(4);
    if (IN(5)) REPS(5) {
        for (int u = vcu; u < 256; u += G) { const int bh = u >> 2, vq = u & 3, b = bh >> 3, h = bh & 7;
            scan_unit<32>(lds, p, (size_t)b * SEQ, SEQ, h, vq, nullptr, p.out + O_PWKV + (size_t)bh * 4096, tid); }
        for (int u = vcu; u < 512; u += G) { const int bh = u >> 2, vq = u & 3, sb = bh >> 3, h = bh & 7;
            scan_unit<16>(lds, p, (size_t)MP + sb * 16, 16, h, vq, p.in[3] + (size_t)bh * 4096, p.out + O_SWKV + (size_t)bh * 4096, tid); }
    }
    SEAM(5);
    if (IN(6)) REPS(6) { for (int m = gw; m < M; m += NGW) post_row(p, m, lane); }
    SEAM(6);
    if (IN(7)) { pg8::Gemm g{MIXB, (const bf16_t*)(ws + WS_WOUT), M, D, D}; pg8::StaticOrder S; S.init(MP, D, D, G, bx, 4);
        EpiRes E{XR, XR + (size_t)MP * D, XR, X2B, ss3, 1.0f, SLAB, 4}; pg8::gemm_phase<EpiRes, true>(lds, g, S, E);
        xcd_barrier(xbar); fix_sample_rows(XR, SLAB, 4, 1.0f, ss3, X2B, gw, NGW, lane); }
    SEAM(7);
    if (IN(8)) { pg8::Gemm g{X2B, (const bf16_t*)(ws + WS_WGU2), M, 2 * FF, D}; pg8::StaticOrder S; S.init(M, 2 * FF, D, G, bx, 0);
        EpiGU E{ACT, ss3}; pg8::gemm_phase<EpiGU>(lds, g, S, E); }
    SEAM(8);
    if (IN(9)) { pg8::Gemm g{ACT, (const bf16_t*)(ws + WS_WD2), M, D, FF}; pg8::StaticOrder S; S.init(MP, D, FF, G, bx, 11);
        EpiRes E{XR, XR + (size_t)MP * D, XR, nullptr, nullptr, 0.5f, SLAB, 4}; pg8::gemm_phase<EpiRes, true>(lds, g, S, E);
        xcd_barrier(xbar); fix_sample_rows(XR, SLAB, 11, 0.5f, nullptr, nullptr, gw, NGW, lane); }
    SEAM(9);
    if (IN(10)) {
        const float* nf = p.in[29];
        for (int m = gw; m < M; m += NGW) {
            f32x4* xr = (f32x4*)(XR + (size_t)m * D) + lane;
            f32x4 v[4]; float sq = 0.f;
#pragma unroll
            for (int j = 0; j < 4; ++j) { v[j] = xr[64 * j]; sq += v[j].x * v[j].x + v[j].y * v[j].y + v[j].z * v[j].z + v[j].w * v[j].w; }
            const float rs = rsqrtf(wave_sum(sq) * (1.f / 1024.f) + NORM_EPS);
#pragma unroll
            for (int j = 0; j < 4; ++j) { const f32x4 g4 = *((const f32x4*)nf + 64 * j + lane); xr[64 * j] = v[j] * rs * g4; }
        }
    }
#ifdef DUMP
    if (lo == 13) {
        const bf16_t* MIXd = (const bf16_t*)(ws + WS_S5);
        const float* Yd = (const float*)(ws + WS_PR); const bf16_t* SGd = (const bf16_t*)(ws + WS_G); const bf16_t* SRd = (const bf16_t*)(ws + WS_S5);
        const bf16_t* PAd = (const bf16_t*)(ws + WS_PA);
        for (int m = gw; m < M; m += NGW)
            for (int c = lane; c < D; c += 64) { float v = 0.f;
                if (DUMP == 2 && c < 512) v = bf2f(MIXd[(size_t)m * D + c]);
                if (DUMP == 3 && c >= 512) v = bf2f(MIXd[(size_t)m * D + c]);
                if (DUMP == 4 && c < 512) v = Yd[(size_t)m * RW + c];
                if (DUMP == 5 && c < 512) v = bf2f(SGd[(size_t)m * RW + c]);
                if (DUMP == 6 && c < 512) v = bf2f(SRd[(size_t)m * RW + c]);
                if (DUMP == 7 && c < 512) v = bf2f(PAd[(size_t)m * AC + c]);
                if (DUMP == 8 && c < 128) v = bf2f(((const bf16_t*)(ws + WS_PR))[(size_t)m * RC + 1664 + c]);
                if (DUMP == 9 && c < 128) v = bf2f(((const bf16_t*)(ws + WS_GL))[(size_t)(m & 511) * 128 + c]);
                XR[(size_t)m * D + c] = v; }
    }
#endif
#undef IN
#undef SEAM
}

extern "C" void kernel_launch(void* const* d_in, const int* in_sizes, int n_in, void* d_out, int out_size, void* d_ws, size_t ws_size, hipStream_t stream) {
    static int grid = 0;
    if (grid == 0) {
        if (n_in != 30 || ws_size < WS_END) { fprintf(stderr, "kernel_launch: unexpected n_in %d or ws_size %zu (< %zu)\n", n_in, ws_size, (size_t)WS_END); grid = -1; return; }
        int dev = 0, cus = 0, per_cu = 0;
        (void)hipGetDevice(&dev); (void)hipDeviceGetAttribute(&cus, hipDeviceAttributeMultiprocessorCount, dev);
        if (hipFuncSetAttribute((const void*)fwd_kernel, hipFuncAttributeMaxDynamicSharedMemorySize, LDS_BYTES) != hipSuccess) { fprintf(stderr, "kernel_launch: hipFuncSetAttribute failed\n"); grid = -1; return; }
        if (hipOccupancyMaxActiveBlocksPerMultiprocessor(&per_cu, (const void*)fwd_kernel, 512, LDS_BYTES) != hipSuccess || per_cu < 1) { fprintf(stderr, "kernel_launch: occupancy query failed (%d)\n", per_cu); (void)hipGetLastError(); per_cu = 1; }
        grid = cus * per_cu;
    }
    if (grid < 0) return;
    Params p{};
    for (int i = 0; i < 30; ++i) p.in[i] = (const float*)d_in[i];
    p.out = (float*)d_out; p.ws = (unsigned char*)d_ws;
    (void)hipMemsetAsync(d_ws, 0, XCD_BAR_WORDS * 4, stream);
#ifndef MULTI_LAUNCH
#define MULTI_LAUNCH 0
#endif
#ifndef NPH
#define NPH 11

#endif
#if MULTI_LAUNCH
    for (int k = 0; k < NPH; ++k) { p.ph_lo = k; p.ph_hi = k + 1; hipLaunchKernelGGL(fwd_kernel, dim3(grid), dim3(512), LDS_BYTES, stream, p); }
#ifdef DUMP
    p.ph_lo = 13; p.ph_hi = 14; hipLaunchKernelGGL(fwd_kernel, dim3(grid), dim3(512), LDS_BYTES, stream, p);
#endif
#else
    p.ph_lo = 0; p.ph_hi = 11;
    void* args[] = {&p};
    hipError_t e = hipLaunchCooperativeKernel((const void*)fwd_kernel, dim3(grid), dim3(512), args, LDS_BYTES, stream);
    if (e != hipSuccess) fprintf(stderr, "kernel_launch: cooperative launch failed: %s (grid %d)\n", hipGetErrorString(e), grid);
#endif
}
```

```cpp
#include <hip/hip_runtime.h>


#include <hip/hip_cooperative_groups.h>
#include <cstdio>
namespace cg = cooperative_groups;

#define LAS __attribute__((address_space(3)))
typedef unsigned short bf16_t;
typedef short bf16x8 __attribute__((ext_vector_type(8)));
typedef float f32x4 __attribute__((ext_vector_type(4)));
typedef float f32x2 __attribute__((ext_vector_type(2)));
typedef unsigned u32x4 __attribute__((ext_vector_type(4)));
typedef unsigned u32x2 __attribute__((ext_vector_type(2)));

constexpr int MP = 65536, MS = 256, M = MP + MS, D = 1024, FF = 2816, NIN = 3328, RC = 1792, AC = 1536, RW = 512;
constexpr int SEQ = 8192;
constexpr float NORM_EPS = 1e-5f, GN_EPS = 64e-5f;
constexpr size_t O_YP = 0, O_YS = 67108864, O_PSH = 67371008, O_PWKV = 67385344, O_PK = 67647488, O_PV = 69744640,
                 O_SSH = 71841792, O_SWKV = 71870464, O_SK = 72394752, O_SV = 72525824;
constexpr size_t SSB = (size_t)M * 4;
constexpr size_t WS_SS1 = 65536, WS_SS2 = WS_SS1 + SSB, WS_SS3 = WS_SS2 + SSB, WS_SS4 = WS_SS3 + SSB;
constexpr size_t WS_BON = 2097152;
constexpr size_t WS_W = 5242880;
constexpr size_t WS_WGU1 = WS_W, WS_WD1 = WS_WGU1 + (size_t)2 * FF * D * 2, WS_WIN = WS_WD1 + (size_t)D * FF * 2, WS_WOUT = WS_WIN + (size_t)NIN * D * 2,
                 WS_WGU2 = WS_WOUT + (size_t)D * D * 2, WS_WD2 = WS_WGU2 + (size_t)2 * FF * D * 2, WS_WL = WS_WD2 + (size_t)D * FF * 2,
                 WS_AL = WS_WL + 512 * 64 * 2, WS_GL = WS_AL + 512 * 64 * 2, WS_WEND = WS_GL + 512 * 128 * 2;
constexpr size_t WS_XB = WS_WEND;
constexpr size_t WS_PR = WS_XB + (size_t)M * D * 2;
constexpr size_t WS_PA = WS_PR + (size_t)M * RC * 2;
constexpr size_t WS_S5 = WS_PA + (size_t)M * AC * 2;
constexpr size_t S5B = (size_t)M * RW * 2;
constexpr size_t WS_G = WS_S5 + 5 * S5B;
constexpr size_t WS_INV = WS_G + S5B;
constexpr size_t WS_SLAB = WS_INV + (size_t)M * 8 * 4;
constexpr size_t WS_END = WS_SLAB + (size_t)11 * MS * D * 4;
constexpr int LDS_BYTES = 131072 + 2048;

typedef __bf16 bf16x2_t __attribute__((ext_vector_type(2)));
__device__ __forceinline__ unsigned cvt_pk_bf16(float lo, float hi) { const f32x2 v = {lo, hi}; return __builtin_bit_cast(unsigned, __builtin_convertvector(v, bf16x2_t)); }
__device__ __forceinline__ float bf2f(unsigned short u) { return __builtin_bit_cast(float, (unsigned)u << 16); }
__device__ __forceinline__ float bflo(unsigned u) { return __builtin_bit_cast(float, u << 16); }
__device__ __forceinline__ float bfhi(unsigned u) { return __builtin_bit_cast(float, u & 0xffff0000u); }
__device__ __forceinline__ unsigned short f2bf(float f) { return __builtin_bit_cast(unsigned short, (__bf16)f); }
__device__ __forceinline__ float wave_sum(float v) {
#pragma unroll
    for (int o = 1; o < 64; o <<= 1) v += __shfl_xor(v, o);
    return v;
}
__device__ __forceinline__ float wave_max(float v) {
#pragma unroll
    for (int o = 1; o < 64; o <<= 1) v = fmaxf(v, __shfl_xor(v, o));
    return v;
}
template <int CTRL> __device__ __forceinline__ float dppf(float v) { return __builtin_bit_cast(float, __builtin_amdgcn_mov_dpp(__builtin_bit_cast(int, v), CTRL, 0xF, 0xF, true)); }
__device__ __forceinline__ float row16_sum(float v) { v += dppf<0xB1>(v); v += dppf<0x4E>(v); v += dppf<0x141>(v); v += dppf<0x140>(v); return v; }
__device__ __forceinline__ float row8_sum(float v) { v += dppf<0xB1>(v); v += dppf<0x4E>(v); v += dppf<0x141>(v); return v; }
__device__ __forceinline__ float fast_exp(float x) { return __builtin_amdgcn_exp2f(x * 1.44269504089f); }
__device__ __forceinline__ float sigmoidf_(float x) { return __builtin_amdgcn_rcpf(1.f + fast_exp(-x)); }

__device__ __forceinline__ float xsum_quads(float v) {
    unsigned u = __builtin_bit_cast(unsigned, v);
    auto r = __builtin_amdgcn_permlane16_swap(u, u, false, false);
    v = __builtin_bit_cast(float, (unsigned)r[0]) + __builtin_bit_cast(float, (unsigned)r[1]);
    u = __builtin_bit_cast(unsigned, v);
    auto q = __builtin_amdgcn_permlane32_swap(u, u, false, false);
    return __builtin_bit_cast(float, (unsigned)q[0]) + __builtin_bit_cast(float, (unsigned)q[1]);
}

namespace pg8 {
constexpr int BM = 256, BK = 64, HALF = 128, HTB = HALF * BK * 2, STAGE_BYTES = 8 * HTB, NXCD = 8, WGM = 8;
__host__ __device__ __forceinline__ int lds_byte(int r, int c) { const int st = (r >> 4) * 2 + (c >> 5), rr = r & 15, cc = c & 31, ob = rr * 64 + cc * 2; return st * 1024 + (ob ^ (((ob >> 9) & 1) << 5)); }
__host__ __device__ __forceinline__ void stage_rc(int b, int& R, int& C) { const int st = b / 1024, sb = b % 1024, swz = sb ^ (((sb >> 9) & 1) << 5); R = (st >> 1) * 16 + swz / 64; C = (st & 1) * 32 + (swz % 64) / 2; }
__host__ __device__ __forceinline__ int perm32(int rho) { const int n = rho >> 4, i = rho & 15; return 8 * (i >> 2) + 4 * n + (i & 3); }
struct Unit { int pm, pk;
    __device__ __forceinline__ int pn() const { return pk & 0xff; } __device__ __forceinline__ int kt0() const { return (pk >> 8) & 0xff; }
    __device__ __forceinline__ int nt() const { return (pk >> 16) & 0xff; } __device__ __forceinline__ int slice() const { return pk >> 24; } };
struct Gemm { const bf16_t* A; const bf16_t* Bt; int M, N, K; };
struct StaticOrder {
    int nM, nN, nwg, G, c, ntf, nsl, nts;
    __device__ __forceinline__ void init(int M_, int N_, int K_, int G_, int c_, int nsl_) { nM = M_ / BM; nN = N_ / BM; nwg = nM * nN; G = G_; c = c_; ntf = K_ / BK; nsl = nsl_; nts = nsl_ ? ntf / nsl_ : 0; }
    __device__ __forceinline__ bool next(int i, Unit& u) const {
        const long L = (long)i * G + c;
        if (L >= nwg) {
            const long sidx = L - nwg; if (sidx >= (long)nN * nsl) return false;
            u.pm = nM; u.pk = (int)(sidx % nN) | (((int)(sidx / nN) * nts) << 8) | (nts << 16) | (1 << 24); return true;
        }
        int wgid = (int)L; { const int q = nwg / NXCD, r = nwg % NXCD, xcd = wgid % NXCD, off = wgid / NXCD; wgid = (xcd < r ? xcd * (q + 1) : r * (q + 1) + (xcd - r) * q) + off; }
        const int nig = WGM * nN, gid = wgid / nig, fm = gid * WGM, gsz = (nM - fm) < WGM ? (nM - fm) : WGM;
        u.pm = fm + ((wgid % nig) % gsz); u.pk = ((wgid % nig) / gsz) | (ntf << 16); return true;
    }
};

template <class Epi, bool SLICED = false>
__device__ __forceinline__ void gemm_phase(LAS unsigned char* lds, const Gemm g, const StaticOrder& S, const Epi& E) {
    const int tid = threadIdx.x, wid = __builtin_amdgcn_readfirstlane(tid >> 6), lane = tid & 63, wr = wid >> 2, wc = wid & 3, fr = lane & 15, fq = lane >> 4;
    const int K = g.K;
    unsigned voffA[2], voffB[2];
#pragma unroll
    for (int i = 0; i < 2; ++i) { int R, C; stage_rc(tid * 16 + i * 8192, R, C); const int Rb = Epi::PERM ? ((R & ~31) + perm32(R & 31)) : R;
        voffA[i] = (unsigned)(R * K + C) * 2u; voffB[i] = (unsigned)(Rb * K + C) * 2u; }
    const size_t kstep = (size_t)(BK * 2);
    const size_t hstep = (size_t)HALF * K * 2;
    const size_t tstep = 2 * hstep;
    const unsigned ldsw = (unsigned)wid * 1024u;
    const int aoff = lds_byte(wr * 64 + fr, fq * 8), boff = lds_byte(wc * 32 + fr, fq * 8);
#define PG8_SA(b, h) (((b) * 2 + (h)) * HTB)
#define PG8_SB(b, h) ((4 + (b) * 2 + (h)) * HTB)
#define PG8_STAGE(bufoff, gbase, voff) do { _Pragma("unroll") for (int _i = 0; _i < 2; ++_i) \
        __builtin_amdgcn_global_load_lds((const unsigned*)((const char*)(gbase) + (voff)[_i]), (LAS unsigned*)(lds + (bufoff) + ldsw + _i * 8192), 16, 0, 0); } while (0)
#define PG8_LDA(dst, b, h) do { _Pragma("unroll") for (int m = 0; m < 4; ++m) _Pragma("unroll") for (int k = 0; k < 2; ++k) dst[m][k] = *(const LAS bf16x8*)(lds + PG8_SA(b, h) + aoff + m * 2048 + k * 1024); } while (0)
#define PG8_LDB(dst, b, h) do { _Pragma("unroll") for (int n = 0; n < 2; ++n) _Pragma("unroll") for (int k = 0; k < 2; ++k) dst[n][k] = *(const LAS bf16x8*)(lds + PG8_SB(b, h) + boff + n * 2048 + k * 1024); } while (0)
#define PG8_MMA(ai, bj, At, Bt) do { __builtin_amdgcn_s_setprio(1); _Pragma("unroll") for (int m = 0; m < 4; ++m) _Pragma("unroll") for (int n = 0; n < 2; ++n) _Pragma("unroll") for (int k = 0; k < 2; ++k) \
        acc[ai][bj][m][n] = __builtin_amdgcn_mfma_f32_16x16x32_bf16(Bt[n][k], At[m][k], acc[ai][bj][m][n], 0, 0, 0); __builtin_amdgcn_s_setprio(0); } while (0)
#define PG8_WAIT_V(n) asm volatile("s_waitcnt vmcnt(" #n ")" ::: "memory")
#define PG8_WAIT_L(n) asm volatile("s_waitcnt lgkmcnt(" #n ")" ::: "memory")
#define PG8_BAR __builtin_amdgcn_s_barrier()
#define PG8_SCHED __builtin_amdgcn_sched_barrier(0)
    Unit cur, nxt; int ui = 0;
    if (!S.next(0, cur)) return;
    f32x4 acc[2][2][4][2];
#pragma unroll
    for (int a = 0; a < 2; ++a)
#pragma unroll
        for (int b = 0; b < 2; ++b)
#pragma unroll
            for (int m = 0; m < 4; ++m)
#pragma unroll
                for (int n = 0; n < 2; ++n) acc[a][b][m][n] = (f32x4){0.f, 0.f, 0.f, 0.f};
    bf16x8 At[4][2], B0[2][2], B1[2][2];
    typename Epi::Pre pre = E.prefetch(cur, wr, fr);
    const char* cA = (const char*)g.A + (size_t)cur.pm * tstep + (SLICED ? (size_t)cur.kt0() * kstep : 0); const char* cB = (const char*)g.Bt + (size_t)cur.pn() * tstep + (SLICED ? (size_t)cur.kt0() * kstep : 0);
    PG8_STAGE(PG8_SB(0, 0), cB, voffB); PG8_STAGE(PG8_SA(0, 0), cA, voffA); PG8_STAGE(PG8_SB(0, 1), cB + hstep, voffB); PG8_STAGE(PG8_SA(0, 1), cA + hstep, voffA);
    if (wr == 1) PG8_BAR;
    PG8_WAIT_V(4); PG8_BAR;
    PG8_STAGE(PG8_SB(1, 0), cB + kstep, voffB); PG8_STAGE(PG8_SA(1, 0), cA + kstep, voffA); PG8_STAGE(PG8_SB(1, 1), cB + hstep + kstep, voffB);
    PG8_WAIT_V(6); PG8_BAR;
    for (;;) {
        const bool has_next = S.next(ui + 1, nxt);
        const char* nA = has_next ? (const char*)g.A + (size_t)nxt.pm * tstep + (SLICED ? (size_t)nxt.kt0() * kstep : 0) : cA; const char* nB = has_next ? (const char*)g.Bt + (size_t)nxt.pn() * tstep + (SLICED ? (size_t)nxt.kt0() * kstep : 0) : cB;
        const int nt = SLICED ? cur.nt() : K / BK;
        for (int t = 0; t < nt; t += 2) {
            const bool last = (t == nt - 2);
            const char* a1 = cA + (size_t)(t + 1) * kstep;
            const char* a2 = last ? nA : cA + (size_t)(t + 2) * kstep; const char* b2 = last ? nB : cB + (size_t)(t + 2) * kstep;
            const char* a3 = a2 + kstep; const char* b3 = b2 + kstep;
            PG8_LDB(B0, 0, 0); PG8_SCHED; PG8_LDA(At, 0, 0); PG8_STAGE(PG8_SA(1, 1), a1 + hstep, voffA);
            PG8_WAIT_L(8); PG8_BAR; PG8_WAIT_L(0); PG8_MMA(0, 0, At, B0); PG8_BAR; PG8_SCHED;
            PG8_LDB(B1, 0, 1); PG8_STAGE(PG8_SB(0, 0), b2, voffB);
            PG8_BAR; PG8_WAIT_L(0); PG8_MMA(0, 1, At, B1); PG8_BAR;
            PG8_LDA(At, 0, 1); PG8_STAGE(PG8_SA(0, 0), a2, voffA);
            PG8_BAR; PG8_WAIT_L(0); PG8_MMA(1, 0, At, B0); PG8_BAR; PG8_SCHED;
            PG8_STAGE(PG8_SB(0, 1), b2 + hstep, voffB);
            PG8_WAIT_V(6); PG8_BAR; PG8_MMA(1, 1, At, B1); PG8_BAR;
            PG8_LDB(B0, 1, 0); PG8_SCHED; PG8_LDA(At, 1, 0); PG8_STAGE(PG8_SA(0, 1), a2 + hstep, voffA);
            PG8_WAIT_L(8); PG8_BAR; PG8_WAIT_L(0); PG8_MMA(0, 0, At, B0); PG8_BAR; PG8_SCHED;
            PG8_LDB(B1, 1, 1); PG8_STAGE(PG8_SB(1, 0), b3, voffB);
            PG8_BAR; PG8_WAIT_L(0); PG8_MMA(0, 1, At, B1); PG8_BAR;
            PG8_LDA(At, 1, 1); PG8_STAGE(PG8_SA(1, 0), a3, voffA);
            PG8_BAR; PG8_WAIT_L(0); PG8_MMA(1, 0, At, B0); PG8_BAR; PG8_SCHED;
            PG8_STAGE(PG8_SB(1, 1), b3 + hstep, voffB);
            PG8_WAIT_V(6); PG8_BAR; PG8_MMA(1, 1, At, B1); PG8_BAR;
        }
        E(acc, cur, wr, wc, fr, fq, pre);
        if (!has_next) break;
        pre = E.prefetch(nxt, wr, fr);
#pragma unroll
        for (int a = 0; a < 2; ++a)
#pragma unroll
            for (int b = 0; b < 2; ++b)
#pragma unroll
                for (int m = 0; m < 4; ++m)
#pragma unroll
                    for (int n = 0; n < 2; ++n) acc[a][b][m][n] = (f32x4){0.f, 0.f, 0.f, 0.f};
        cur = nxt; cA = nA; cB = nB; ++ui;
    }
    PG8_WAIT_V(0);
    if (wr == 0) PG8_BAR;
    PG8_BAR;
#undef PG8_SA
#undef PG8_SB
#undef PG8_STAGE
#undef PG8_LDA
#undef PG8_LDB
#undef PG8_MMA
#undef PG8_WAIT_V
#undef PG8_WAIT_L
#undef PG8_BAR
#undef PG8_SCHED
}
}

struct EpiGU {
    static constexpr bool PERM = true;
    bf16_t* O; const float* ss;
    struct Pre { float s[8]; };
    __device__ __forceinline__ Pre prefetch(const pg8::Unit& u, int wr, int fr) const { Pre q; const int row0 = u.pm * 256 + wr * 64 + fr;
#pragma unroll
        for (int i = 0; i < 8; ++i) q.s[i] = ss[row0 + (i >> 2) * 128 + (i & 3) * 16];
        return q; }
    __device__ __forceinline__ void operator()(const f32x4 (&acc)[2][2][4][2], const pg8::Unit& u, int wr, int wc, int fr, int fq, const Pre& pre) const {
        const int row0 = u.pm * 256 + wr * 64 + fr, col0 = u.pn() * 128 + wc * 32 + 8 * fq;
#pragma unroll
        for (int ai = 0; ai < 2; ++ai)
#pragma unroll
            for (int m = 0; m < 4; ++m) {
                const int row = row0 + ai * 128 + m * 16;
                const float rs = rsqrtf(pre.s[ai * 4 + m] * (1.f / 1024.f) + NORM_EPS);
                f32x4 ov[2];
#pragma unroll
                for (int n = 0; n < 2; ++n) {
                    const f32x4 g4 = acc[ai][0][m][n] * rs, u4 = acc[ai][1][m][n] * rs;
                    const f32x4 t4 = g4 * (-1.44269504089f);
                    f32x4 e4; e4.x = __builtin_amdgcn_exp2f(t4.x); e4.y = __builtin_amdgcn_exp2f(t4.y); e4.z = __builtin_amdgcn_exp2f(t4.z); e4.w = __builtin_amdgcn_exp2f(t4.w);
                    const f32x4 d4 = e4 + 1.0f;
                    const float rxy = __builtin_amdgcn_rcpf(d4.x * d4.y), rzw = __builtin_amdgcn_rcpf(d4.z * d4.w);
                    const f32x4 r4 = (f32x4){rxy, rxy, rzw, rzw} * (f32x4){d4.y, d4.x, d4.w, d4.z};
                    ov[n] = (g4 * u4) * r4;
                }
                u32x4 w; w.x = cvt_pk_bf16(ov[0].x, ov[0].y); w.y = cvt_pk_bf16(ov[0].z, ov[0].w); w.z = cvt_pk_bf16(ov[1].x, ov[1].y); w.w = cvt_pk_bf16(ov[1].z, ov[1].w);
                *(u32x4*)(O + (size_t)row * FF + col0) = w;
            }
    }
};
struct EpiRes {
    static constexpr bool PERM = true;
    const float* resP; const float* resS; float* XR; bf16_t* XBo; float* ssn; float scale; float* slab; int nts;
    struct Pre {};
    __device__ __forceinline__ Pre prefetch(const pg8::Unit&, int, int) const { return Pre{}; }
    __device__ __forceinline__ void operator()(const f32x4 (&acc)[2][2][4][2], const pg8::Unit& u, int wr, int wc, int fr, int fq, const Pre&) const {
        const int row0 = u.pm * 256 + wr * 64 + fr, col0 = u.pn() * 256 + wc * 32 + 8 * fq;
        if (u.slice()) {
            float* sl = slab + (size_t)(u.kt0() / nts) * (MS * D) + (size_t)(row0 - MP) * D + col0;
#pragma unroll
            for (int ai = 0; ai < 2; ++ai)
#pragma unroll
                for (int m = 0; m < 4; ++m)
#pragma unroll
                    for (int bj = 0; bj < 2; ++bj) { float* q = sl + (size_t)(ai * 128 + m * 16) * D + bj * 128;
                        *(f32x4*)q = acc[ai][bj][m][0]; *(f32x4*)(q + 4) = acc[ai][bj][m][1]; }
            return;
        }
        f32x4 q0[2], q1[2];
#pragma unroll
        for (int it = 0; it < 2; ++it) { const int row = row0 + (it >> 3) * 128 + ((it >> 1) & 3) * 16;
            const float* rp = (row < MP ? resP + (size_t)row * D : resS + (size_t)(row - MP) * D) + col0 + (it & 1) * 128;
            q0[it] = *(const f32x4*)rp; q1[it] = *(const f32x4*)(rp + 4); }
        float sq = 0.f;
#pragma unroll
        for (int it = 0; it < 16; ++it) {
            const int ai = it >> 3, m = (it >> 1) & 3, bj = it & 1;
            const int row = row0 + ai * 128 + m * 16, c = col0 + bj * 128;
            const f32x4 r0 = q0[it & 1], r1 = q1[it & 1];
            if (it + 2 < 16) { const int it2 = it + 2; const int row2 = row0 + (it2 >> 3) * 128 + ((it2 >> 1) & 3) * 16;
                const float* rp = (row2 < MP ? resP + (size_t)row2 * D : resS + (size_t)(row2 - MP) * D) + col0 + (it2 & 1) * 128;
                q0[it & 1] = *(const f32x4*)rp; q1[it & 1] = *(const f32x4*)(rp + 4); }
            const f32x4 v0 = r0 + scale * acc[ai][bj][m][0], v1 = r1 + scale * acc[ai][bj][m][1];
            *(f32x4*)(XR + (size_t)row * D + c) = v0; *(f32x4*)(XR + (size_t)row * D + c + 4) = v1;
            sq += v0.x * v0.x + v0.y * v0.y + v0.z * v0.z + v0.w * v0.w + v1.x * v1.x + v1.y * v1.y + v1.z * v1.z + v1.w * v1.w;
            if (XBo) { u32x4 w; w.x = cvt_pk_bf16(v0.x, v0.y); w.y = cvt_pk_bf16(v0.z, v0.w); w.z = cvt_pk_bf16(v1.x, v1.y); w.w = cvt_pk_bf16(v1.z, v1.w);
                *(u32x4*)(XBo + (size_t)row * D + c) = w; }
            if (bj == 1) { if (ssn) { const float tot = xsum_quads(sq); if (fq == 0) atomicAdd(ssn + row, tot); } sq = 0.f; }
        }
    }
};
struct EpiIn {
    static constexpr bool PERM = true;
    bf16_t* PR; bf16_t* PA; const float* ss; float* out;
    struct Pre { float s[8]; };
    __device__ __forceinline__ Pre prefetch(const pg8::Unit& u, int wr, int fr) const { Pre q; const int row0 = u.pm * 256 + wr * 64 + fr;
#pragma unroll
        for (int i = 0; i < 8; ++i) q.s[i] = ss[row0 + (i >> 2) * 128 + (i & 3) * 16];
        return q; }
    __device__ __forceinline__ void operator()(const f32x4 (&acc)[2][2][4][2], const pg8::Unit& u, int wr, int wc, int fr, int fq, const Pre& pre) const {
        const int row0 = u.pm * 256 + wr * 64 + fr, col0 = u.pn() * 256 + wc * 32 + 8 * fq;
        const int pn = u.pn();
#pragma unroll
        for (int ai = 0; ai < 2; ++ai)
#pragma unroll
            for (int m = 0; m < 4; ++m) {
                const int row = row0 + ai * 128 + m * 16;
                const float rs = rsqrtf(pre.s[ai * 4 + m] * (1.f / 1024.f) + NORM_EPS);
#pragma unroll
                for (int bj = 0; bj < 2; ++bj) {
                    const int c = col0 + bj * 128;
                    const f32x4 v0 = acc[ai][bj][m][0] * rs, v1 = acc[ai][bj][m][1] * rs;
                    u32x4 w; w.x = cvt_pk_bf16(v0.x, v0.y); w.y = cvt_pk_bf16(v0.z, v0.w); w.z = cvt_pk_bf16(v1.x, v1.y); w.w = cvt_pk_bf16(v1.z, v1.w);
                    float* fo = nullptr;
                    if (pn < 7) {
                        *(u32x4*)(PR + (size_t)row * RC + c) = w;
                        if (row < MP) { if ((row & (SEQ - 1)) == SEQ - 1) fo = out + O_PSH + (size_t)(row >> 13) * RC + c; }
                        else { const int r = row - MP; if ((r & 15) == 15) fo = out + O_SSH + (size_t)(r >> 4) * RC + c; }
                    } else {
                        const int ca = c - RC;
                        *(u32x4*)(PA + (size_t)row * AC + ca) = w;
                        if (pn >= 9) {
                            const int cc = ca - 512, isv = cc >> 9, c2 = cc & 511, h = c2 >> 6, d = c2 & 63;
                            if (row < MP) { const int t = row & (SEQ - 1), b = row >> 13;
                                if (t >= SEQ - 512) fo = out + (isv ? O_PV : O_PK) + ((size_t)(b * 8 + h) * 512 + (t - (SEQ - 512))) * 64 + d; }
                            else { const int r = row - MP, sb = r >> 4, st = r & 15;
                                fo = out + (isv ? O_SV : O_SK) + ((size_t)(sb * 8 + h) * 16 + st) * 64 + d; }
                        }
                    }
                    if (fo) { *(f32x4*)fo = v0; *(f32x4*)(fo + 4) = v1; }
                }
            }
    }
};

__device__ __forceinline__ void tr_item(const float* W, int K, int N, bf16_t* WT, const float* scale, int mode, LAS float* scr, int item, int lane) {
    const int nblk = N / 32, kb = item / nblk, nb = item % nblk, k0 = 64 * kb, n0 = 32 * nb;
#pragma unroll 8
    for (int i = 0; i < 32; ++i) { const int kk = 2 * i + (lane >> 5); float v = W[(size_t)(k0 + kk) * N + n0 + (lane & 31)]; if (scale) v *= scale[k0 + kk]; scr[kk * 33 + (lane & 31)] = v; }
    asm volatile("s_waitcnt lgkmcnt(0)" ::: "memory");
    const int c = lane & 7;
#pragma unroll
    for (int j = 0; j < 4; ++j) { const int n = (lane >> 3) + 8 * j; const LAS float* s = scr + (8 * c) * 33 + n;
        u32x4 o; o.x = cvt_pk_bf16(s[0 * 33], s[1 * 33]); o.y = cvt_pk_bf16(s[2 * 33], s[3 * 33]); o.z = cvt_pk_bf16(s[4 * 33], s[5 * 33]); o.w = cvt_pk_bf16(s[6 * 33], s[7 * 33]);
        const int ng = n0 + n; const int rr = mode == 0 ? ng : (((ng >> 7) << 8) + (ng & 127) + (mode == 2 ? 128 : 0));
        *(u32x4*)(WT + (size_t)rr * K + k0 + 8 * c) = o; }
    asm volatile("s_waitcnt lgkmcnt(0)" ::: "memory");
}

struct Params { const float* in[30]; float* out; unsigned char* ws; int ph_lo, ph_hi; };

__device__ __forceinline__ void phase0(const Params& p, LAS unsigned char* lds, int gw, int NGW, int wave, int lane) {
    unsigned char* ws = p.ws;
    LAS float* scr = (LAS float*)(lds + wave * 8448);
    constexpr int I_GU = (D / 64) * (FF / 32), I_DN = (FF / 64) * (D / 32), I_IN = (D / 64) * (NIN / 32), I_OUT = (D / 64) * (D / 32), I_L = 16, I_GL = 32;
    constexpr int NITEMS = 4 * I_GU + 2 * I_DN + I_IN + I_OUT + 2 * I_L + I_GL;
    for (int it = gw; it < NITEMS; it += NGW) {
        int r = it;
        if (r < I_GU) { tr_item(p.in[7], D, FF, (bf16_t*)(ws + WS_WGU1), p.in[6], 1, scr, r, lane); continue; } r -= I_GU;
        if (r < I_GU) { tr_item(p.in[8], D, FF, (bf16_t*)(ws + WS_WGU1), p.in[6], 2, scr, r, lane); continue; } r -= I_GU;
        if (r < I_DN) { tr_item(p.in[9], FF, D, (bf16_t*)(ws + WS_WD1), nullptr, 0, scr, r, lane); continue; } r -= I_DN;
        if (r < I_IN) { tr_item(p.in[11], D, NIN, (bf16_t*)(ws + WS_WIN), p.in[10], 0, scr, r, lane); continue; } r -= I_IN;
        if (r < I_OUT) { tr_item(p.in[24], D, D, (bf16_t*)(ws + WS_WOUT), nullptr, 0, scr, r, lane); continue; } r -= I_OUT;
        if (r < I_GU) { tr_item(p.in[26], D, FF, (bf16_t*)(ws + WS_WGU2), p.in[25], 1, scr, r, lane); continue; } r -= I_GU;
        if (r < I_GU) { tr_item(p.in[27], D, FF, (bf16_t*)(ws + WS_WGU2), p.in[25], 2, scr, r, lane); continue; } r -= I_GU;
        if (r < I_DN) { tr_item(p.in[28], FF, D, (bf16_t*)(ws + WS_WD2), nullptr, 0, scr, r, lane); continue; } r -= I_DN;
        if (r < I_L) { tr_item(p.in[14], 64, 512, (bf16_t*)(ws + WS_WL), nullptr, 0, scr, r, lane); continue; } r -= I_L;
        if (r < I_L) { tr_item(p.in[16], 64, 512, (bf16_t*)(ws + WS_AL), nullptr, 0, scr, r, lane); continue; } r -= I_L;
        tr_item(p.in[17], 128, 512, (bf16_t*)(ws + WS_GL), nullptr, 0, scr, r, lane);
    }
    bf16_t* XB = (bf16_t*)(ws + WS_XB);
    float* SLAB = (float*)(ws + WS_SLAB);
    float* ss1 = (float*)(ws + WS_SS1);
    for (int m = gw; m < M; m += NGW) {
        const float* xrow = m < MP ? p.in[0] + (size_t)m * D : p.in[1] + (size_t)(m - MP) * D;
        const f32x4* xr = (const f32x4*)xrow + lane;
        f32x4 v[4]; float s = 0.f;
#pragma unroll
        for (int j = 0; j < 4; ++j) { v[j] = xr[64 * j]; s += v[j].x * v[j].x + v[j].y * v[j].y + v[j].z * v[j].z + v[j].w * v[j].w; }
        s = wave_sum(s);
        if (lane == 0) ss1[m] = s;
        if (m >= MP) { f32x4* xo = (f32x4*)(p.out + (size_t)m * D) + lane;
#pragma unroll
            for (int j = 0; j < 4; ++j) xo[64 * j] = v[j]; }
        u32x2* o8 = (u32x2*)(XB + (size_t)m * D) + lane;
#pragma unroll
        for (int j = 0; j < 4; ++j) { u32x2 o; o.x = cvt_pk_bf16(v[j].x, v[j].y); o.y = cvt_pk_bf16(v[j].z, v[j].w); o8[64 * j] = o; }
    }
    float* ssz = (float*)(ws + WS_SS2);
    for (int i = gw * 64 + lane; i < 3 * M; i += NGW * 64) ssz[i] = 0.f;
}

__device__ __forceinline__ float ld_prev(const bf16_t* PR, const float* sshift, int row, int col) {
    if (row < MP) { if ((row & (SEQ - 1)) == 0) return 0.f; return bf2f(PR[(size_t)(row - 1) * RC + col]); }
    const int r = row - MP; if ((r & 15) == 0) return sshift[(size_t)(r >> 4) * RC + col];
    return bf2f(PR[(size_t)(row - 1) * RC + col]);
}
__device__ __forceinline__ void up8(const u32x4 u, float (&f)[8]) { f[0] = bflo(u.x); f[1] = bfhi(u.x); f[2] = bflo(u.y); f[3] = bfhi(u.y); f[4] = bflo(u.z); f[5] = bfhi(u.z); f[6] = bflo(u.w); f[7] = bfhi(u.w); }
__device__ __forceinline__ void ld8f(const float* p, float (&f)[8]) { const f32x4 a = *(const f32x4*)p, b = *(const f32x4*)(p + 4); f[0] = a.x; f[1] = a.y; f[2] = a.z; f[3] = a.w; f[4] = b.x; f[5] = b.y; f[6] = b.z; f[7] = b.w; }
__device__ __forceinline__ u32x4 pk8(const float (&o)[8]) { u32x4 w; w.x = cvt_pk_bf16(o[0], o[1]); w.y = cvt_pk_bf16(o[2], o[3]); w.z = cvt_pk_bf16(o[4], o[5]); w.w = cvt_pk_bf16(o[6], o[7]); return w; }
constexpr int LW_PITCH = 144, LG_PITCH = 272, LW_OFF = 0, LA_OFF = 64 * LW_PITCH, LGL_OFF = 2 * 64 * LW_PITCH;
constexpr int PT_OFF = 36864;
constexpr int PT_MU = 0, PT_W0 = 1792, PT_A0 = 2304, PT_KK = 2816, PT_KA = 3328, PT_RK = 3840, PT_N = 4352;
__device__ __forceinline__ void prep_load_params(LAS unsigned char* lds, const Params& p, int tid) {
    LAS float* PT = (LAS float*)(lds + PT_OFF);
    for (int i = tid; i < PT_N; i += 512) {
        float v;
        if (i < PT_W0) v = p.in[12][i]; else if (i < PT_A0) v = p.in[13][i - PT_W0]; else if (i < PT_KK) v = p.in[15][i - PT_A0];
        else if (i < PT_KA) v = p.in[18][i - PT_KK]; else if (i < PT_RK) v = p.in[19][i - PT_KA]; else v = p.in[20][i - PT_RK];
        PT[i] = v;
    }
    __syncthreads();
}
__device__ __forceinline__ void lds8f(const LAS float* q, float (&f)[8]) { const f32x4 a = *(const LAS f32x4*)q, b = *(const LAS f32x4*)(q + 4); f[0] = a.x; f[1] = a.y; f[2] = a.z; f[3] = a.w; f[4] = b.x; f[5] = b.y; f[6] = b.z; f[7] = b.w; }
__device__ __forceinline__ void prep_unit(LAS unsigned char* lds, const Params& p, int u, int lane, int tid, int h_lo, int h_hi) {
    unsigned char* ws = p.ws;
    const bf16_t* PR = (const bf16_t*)(ws + WS_PR);
    const float* sshift = p.in[2];
    const LAS float* PT = (const LAS float*)(lds + PT_OFF);
    const bf16_t* WL = (const bf16_t*)(ws + WS_WL); const bf16_t* AL = (const bf16_t*)(ws + WS_AL); const bf16_t* GL = (const bf16_t*)(ws + WS_GL);
    float* SW = (float*)(ws + WS_XB);
    bf16_t* SR = (bf16_t*)(ws + WS_S5); bf16_t* SK = (bf16_t*)(ws + WS_S5 + S5B); bf16_t* SV = (bf16_t*)(ws + WS_S5 + 2 * S5B);
    bf16_t* SKK = (bf16_t*)(ws + WS_S5 + 3 * S5B); bf16_t* SB = (bf16_t*)(ws + WS_S5 + 4 * S5B); bf16_t* SG = (bf16_t*)(ws + WS_G);
    float* BON = (float*)(ws + WS_BON);
    const int row0 = u * 16, i16 = lane & 15, quad = lane >> 4;
    const int row = row0 + i16;
    const bool zero_prev = row < MP && (row & (SEQ - 1)) == 0;
    const bool st_prev = row >= MP && ((row - MP) & 15) == 0;
    const bf16_t* prow = PR + (size_t)row * RC;
    const bf16_t* pprev = PR + (size_t)(zero_prev || st_prev ? row : row - 1) * RC;
    const float* sprev = sshift + (size_t)(st_prev ? ((row - MP) >> 4) : 0) * RC;
    auto lerp8 = [&](const u32x4 cu, const u32x4 pu, int col, float (&x)[8]) {
        float cf[8], pf[8], mf[8];
        up8(cu, cf);
        if (st_prev) ld8f(sprev + col, pf); else up8(pu, pf);
        lds8f(PT + PT_MU + col, mf);
#pragma unroll
        for (int j = 0; j < 8; ++j) { const float pv = zero_prev ? 0.f : pf[j]; x[j] = cf[j] + (pv - cf[j]) * mf[j]; }
    };
    bf16x8 Bf[8];
    {
        u32x4 cu[8], pu[8];
#pragma unroll
        for (int s8 = 0; s8 < 8; ++s8) { const int col = 1536 + s8 * 32 + quad * 8; cu[s8] = *(const u32x4*)(prow + col); pu[s8] = *(const u32x4*)(pprev + col); }
#pragma unroll
        for (int s8 = 0; s8 < 8; ++s8) {
            float xv[8]; lerp8(cu[s8], pu[s8], 1536 + s8 * 32 + quad * 8, xv);
#pragma unroll
            for (int j = 0; j < 8; ++j) {
                if (s8 < 2) xv[j] = 1.f - 2.f * __builtin_amdgcn_rcpf(1.f + fast_exp(2.f * xv[j]));
                else if (s8 >= 4) xv[j] = sigmoidf_(xv[j]);
            }
            Bf[s8] = __builtin_bit_cast(bf16x8, pk8(xv));
        }
    }
#pragma unroll 1
    for (int h = h_lo; h < h_hi; ++h) {
        { const int r = tid >> 3, ch = tid & 7;
          const u32x4 gwl = *(const u32x4*)(WL + (size_t)(h * 64 + r) * 64 + ch * 8), gal = *(const u32x4*)(AL + (size_t)(h * 64 + r) * 64 + ch * 8);
          u32x4 ggl[2];
#pragma unroll
          for (int i = 0; i < 2; ++i) { const int pz = tid + 512 * i, rr = pz >> 4, c2 = pz & 15; ggl[i] = *(const u32x4*)(GL + (size_t)(h * 64 + rr) * 128 + c2 * 8); }
          __syncthreads();
          *(LAS u32x4*)(lds + LW_OFF + r * LW_PITCH + ch * 16) = gwl;
          *(LAS u32x4*)(lds + LA_OFF + r * LW_PITCH + ch * 16) = gal;
#pragma unroll
          for (int i = 0; i < 2; ++i) { const int pz = tid + 512 * i, rr = pz >> 4, c2 = pz & 15; *(LAS u32x4*)(lds + LGL_OFF + rr * LG_PITCH + c2 * 16) = ggl[i]; } }
        __syncthreads();
        float ssq = 0.f, bs = 0.f;
#pragma unroll 1
        for (int g2 = 0; g2 < 2; ++g2) {
            const int cbase = h * 64 + g2 * 32;
            const int c0 = cbase + 8 * quad;
            const size_t o = (size_t)row * RW + c0;
            const u32x4 rcu = *(const u32x4*)(prow + c0), kcu = *(const u32x4*)(prow + 512 + c0), vcu = *(const u32x4*)(prow + 1024 + c0);
            const u32x4 rpu = *(const u32x4*)(pprev + c0), kpu = *(const u32x4*)(pprev + 512 + c0), vpu = *(const u32x4*)(pprev + 1024 + c0);
            f32x4 aW[2], aA[2], aG[2];
#pragma unroll
            for (int t = 0; t < 2; ++t) {
                const int rl = g2 * 32 + 8 * (i16 >> 2) + 4 * t + (i16 & 3);
                aW[t] = (f32x4){0.f, 0.f, 0.f, 0.f}; aA[t] = aW[t]; aG[t] = aW[t];
#pragma unroll
                for (int ks = 0; ks < 2; ++ks) {
                    const bf16x8 fw = *(const LAS bf16x8*)(lds + LW_OFF + rl * LW_PITCH + (ks * 32 + quad * 8) * 2);
                    const bf16x8 fa = *(const LAS bf16x8*)(lds + LA_OFF + rl * LW_PITCH + (ks * 32 + quad * 8) * 2);
                    aW[t] = __builtin_amdgcn_mfma_f32_16x16x32_bf16(fw, Bf[ks], aW[t], 0, 0, 0);
                    aA[t] = __builtin_amdgcn_mfma_f32_16x16x32_bf16(fa, Bf[2 + ks], aA[t], 0, 0, 0);
                }
#pragma unroll
                for (int ks = 0; ks < 4; ++ks) {
                    const bf16x8 fg = *(const LAS bf16x8*)(lds + LGL_OFF + rl * LG_PITCH + (ks * 32 + quad * 8) * 2);
                    aG[t] = __builtin_amdgcn_mfma_f32_16x16x32_bf16(fg, Bf[4 + ks], aG[t], 0, 0, 0);
                }
            }
            float gg[8], dec[8], av[8], k4[8], kru[8], kbu[8], rs[8], vs[8];
#pragma unroll
            for (int e = 0; e < 8; ++e) gg[e] = aG[e >> 2][e & 3];
            { float w0v[8]; lds8f(PT + PT_W0 + c0, w0v);
#pragma unroll
              for (int e = 0; e < 8; ++e) { const float z = -(w0v[e] + aW[e >> 2][e & 3]);
                  const float sp = fmaxf(z, 0.f) + __logf(1.f + fast_exp(-fabsf(z)));
                  dec[e] = fast_exp(-fast_exp(-sp - 0.5f)); } }
            { float a0v[8]; lds8f(PT + PT_A0 + c0, a0v);
#pragma unroll
              for (int e = 0; e < 8; ++e) av[e] = sigmoidf_(a0v[e] + aA[e >> 2][e & 3]); }
            { float ks_[8], kkv[8], kav[8]; lerp8(kcu, kpu, 512 + c0, ks_); lds8f(PT + PT_KK + c0, kkv); lds8f(PT + PT_KA + c0, kav);
#pragma unroll
              for (int e = 0; e < 8; ++e) { const float kr = ks_[e] * kkv[e]; kru[e] = kr; kbu[e] = kr * av[e]; ssq += kr * kr; k4[e] = ks_[e] * (1.f + (av[e] - 1.f) * kav[e]); } }
            { float rkv[8]; lerp8(rcu, rpu, c0, rs); lds8f(PT + PT_RK + c0, rkv);
#pragma unroll
              for (int e = 0; e < 8; ++e) bs += rs[e] * k4[e] * rkv[e]; }
            lerp8(vcu, vpu, 1024 + c0, vs);
            *(u32x4*)(SG + o) = pk8(gg);
            *(f32x4*)(SW + o) = (f32x4){dec[0], dec[1], dec[2], dec[3]}; *(f32x4*)(SW + o + 4) = (f32x4){dec[4], dec[5], dec[6], dec[7]};
            *(u32x4*)(SK + o) = pk8(k4); *(u32x4*)(SKK + o) = pk8(kru); *(u32x4*)(SB + o) = pk8(kbu);
            *(u32x4*)(SR + o) = pk8(rs); *(u32x4*)(SV + o) = pk8(vs);
        }
        ssq += __shfl_xor(ssq, 16); ssq += __shfl_xor(ssq, 32);
        bs += __shfl_xor(bs, 16); bs += __shfl_xor(bs, 32);
        if (quad == 0) { BON[(size_t)row * 8 + h] = bs; ((float*)(ws + WS_INV))[(size_t)row * 8 + h] = rsqrtf(fmaxf(ssq, 1e-24f)); }
    }
}

__device__ __forceinline__ bf16x8 tr_read2(unsigned a0, unsigned a1) {
    u32x2 r0, r1;
    asm volatile("ds_read_b64_tr_b16 %0, %2\n\tds_read_b64_tr_b16 %1, %3\n\ts_waitcnt lgkmcnt(0)" : "=&v"(r0), "=&v"(r1) : "v"(a0), "v"(a1) : "memory");
    u32x4 w; w.x = r0.x; w.y = r0.y; w.z = r1.x; w.w = r1.y;
    return __builtin_bit_cast(bf16x8, w);
}
__device__ __forceinline__ void tr_read8(unsigned a, bf16x8 (&Av)[4]) {
    u32x2 r0, r1, r2, r3, r4, r5, r6, r7;
    asm volatile("ds_read_b64_tr_b16 %0, %8\n\tds_read_b64_tr_b16 %1, %8 offset:2304\n\t"
                 "ds_read_b64_tr_b16 %2, %8 offset:32\n\tds_read_b64_tr_b16 %3, %8 offset:2336\n\t"
                 "ds_read_b64_tr_b16 %4, %8 offset:64\n\tds_read_b64_tr_b16 %5, %8 offset:2368\n\t"
                 "ds_read_b64_tr_b16 %6, %8 offset:96\n\tds_read_b64_tr_b16 %7, %8 offset:2400\n\ts_waitcnt lgkmcnt(0)"
                 : "=&v"(r0), "=&v"(r1), "=&v"(r2), "=&v"(r3), "=&v"(r4), "=&v"(r5), "=&v"(r6), "=&v"(r7) : "v"(a) : "memory");
    u32x4 w;
    w.x = r0.x; w.y = r0.y; w.z = r1.x; w.w = r1.y; Av[0] = __builtin_bit_cast(bf16x8, w);
    w.x = r2.x; w.y = r2.y; w.z = r3.x; w.w = r3.y; Av[1] = __builtin_bit_cast(bf16x8, w);
    w.x = r4.x; w.y = r4.y; w.z = r5.x; w.w = r5.y; Av[2] = __builtin_bit_cast(bf16x8, w);
    w.x = r6.x; w.y = r6.y; w.z = r7.x; w.w = r7.y; Av[3] = __builtin_bit_cast(bf16x8, w);
}
constexpr int ATT_WL = 10496, VPITCH = 144;
constexpr int QT = 2;
__device__ __forceinline__ void attn_prompt_unit(LAS unsigned char* wl, bf16_t* PA, const float* relb, int u, int lane) {
    const int h = u & 7, qh = (u >> 3) & 1, cb = u >> 4, c = cb & 127, b = cb >> 7;
    const int i16 = lane & 15, quad = lane >> 4;
    const size_t c0 = (size_t)b * SEQ + (size_t)c * 64;
    const size_t q0 = c0 + qh * 32;
    LAS float* tab = (LAS float*)(wl + 9216);
    for (int i = lane; i < 257; i += 64) tab[i] = relb[h * 257 + i] * 1.44269504089f;
    const float tab0 = relb[h * 257] * 1.44269504089f;
    bf16x8 Bq[QT][2];
#pragma unroll
    for (int qt = 0; qt < QT; ++qt)
#pragma unroll
        for (int ks = 0; ks < 2; ++ks) Bq[qt][ks] = *(const bf16x8*)(PA + (q0 + qt * 16 + i16) * AC + h * 64 + ks * 32 + quad * 8);
    f32x4 O[4][QT];
    float mrun[QT], lrun[QT];
#pragma unroll
    for (int qt = 0; qt < QT; ++qt) { mrun[qt] = -1e30f; lrun[qt] = 0.f;
#pragma unroll
        for (int dt = 0; dt < 4; ++dt) O[dt][qt] = (f32x4){0.f, 0.f, 0.f, 0.f}; }
    const unsigned wbase = (unsigned)(unsigned long)wl;
    const int kt0 = (c < 8 ? 8 - c : 0);
    bf16x8 Kc[4][2]; u32x4 Vc[8];
    auto issue_tile = [&](int kt, bf16x8 (&Kx)[4][2], u32x4 (&Vx)[8]) {
        const size_t k0 = c0 - (size_t)(8 - kt) * 64;
#pragma unroll
        for (int kti = 0; kti < 4; ++kti) { const bf16_t* kp = PA + (k0 + kti * 16 + i16) * AC + 512 + h * 64 + quad * 8;
            Kx[kti][0] = *(const bf16x8*)kp; Kx[kti][1] = *(const bf16x8*)(kp + 32); }
#pragma unroll
        for (int i = 0; i < 8; ++i) { const int pz = lane + 64 * i, key = pz >> 3, ch = pz & 7;
            Vx[i] = *(const u32x4*)(PA + (k0 + key) * AC + 1024 + h * 64 + ch * 8); }
    };
    issue_tile(kt0, Kc, Vc);
    for (int kt = kt0; kt <= 8; ++kt) {
#pragma unroll
        for (int i = 0; i < 8; ++i) { const int pz = lane + 64 * i, key = pz >> 3, ch = pz & 7; *(LAS u32x4*)(wl + key * VPITCH + ch * 16) = Vc[i]; }
        bf16x8 Ku[4][2];
#pragma unroll
        for (int kti = 0; kti < 4; ++kti) { Ku[kti][0] = Kc[kti][0]; Ku[kti][1] = Kc[kti][1]; }
        if (kt < 8) issue_tile(kt + 1, Kc, Vc);
        f32x4 St[4][QT];
#pragma unroll
        for (int kti = 0; kti < 4; ++kti) {
#pragma unroll
            for (int qt = 0; qt < QT; ++qt) {
                f32x4 s = {0.f, 0.f, 0.f, 0.f};
                s = __builtin_amdgcn_mfma_f32_16x16x32_bf16(Ku[kti][0], Bq[qt][0], s, 0, 0, 0);
                s = __builtin_amdgcn_mfma_f32_16x16x32_bf16(Ku[kti][1], Bq[qt][1], s, 0, 0, 0);
                St[kti][qt] = s;
            }
        }
        const float sc = 0.125f * 1.44269504089f;
        if (kt < 6) {
#pragma unroll
            for (int kti = 0; kti < 4; ++kti)
#pragma unroll
                for (int qt = 0; qt < QT; ++qt) St[kti][qt] = St[kti][qt] * sc + tab0;
        } else {
#pragma unroll
            for (int kti = 0; kti < 4; ++kti)
#pragma unroll
                for (int qt = 0; qt < QT; ++qt)
#pragma unroll
                    for (int j = 0; j < 4; ++j) {
                        int rel = (kt - 8) * 64 + kti * 16 + quad * 4 + j - (qh * 32 + qt * 16 + i16);
                        rel = rel < -128 ? -128 : (rel > 128 ? 128 : rel);
                        St[kti][qt][j] = St[kti][qt][j] * sc + tab[rel + 128];
                    }
        }
#pragma unroll
        for (int qt = 0; qt < QT; ++qt) {
            float mx = -1e30f;
#pragma unroll
            for (int kti = 0; kti < 4; ++kti)
#pragma unroll
                for (int j = 0; j < 4; ++j) mx = fmaxf(mx, St[kti][qt][j]);
            mx = fmaxf(mx, __shfl_xor(mx, 16)); mx = fmaxf(mx, __shfl_xor(mx, 32));
            const float mnew = fmaxf(mrun[qt], mx);
            const float alpha = __builtin_amdgcn_exp2f(mrun[qt] - mnew);
            mrun[qt] = mnew;
            float ps = 0.f;
#pragma unroll
            for (int kti = 0; kti < 4; ++kti)
#pragma unroll
                for (int j = 0; j < 4; ++j) { const float pv = __builtin_amdgcn_exp2f(St[kti][qt][j] - mnew); St[kti][qt][j] = pv; ps += pv; }
            lrun[qt] = lrun[qt] * alpha + ps;
#pragma unroll
            for (int dt = 0; dt < 4; ++dt) O[dt][qt] = O[dt][qt] * alpha;
        }
#pragma unroll
        for (int ks2 = 0; ks2 < 2; ++ks2) {
            bf16x8 Bp[QT];
#pragma unroll
            for (int qt = 0; qt < QT; ++qt) {
                u32x4 w; const f32x4 p0 = St[2 * ks2][qt], p1 = St[2 * ks2 + 1][qt];
                w.x = cvt_pk_bf16(p0.x, p0.y); w.y = cvt_pk_bf16(p0.z, p0.w); w.z = cvt_pk_bf16(p1.x, p1.y); w.w = cvt_pk_bf16(p1.z, p1.w);
                Bp[qt] = __builtin_bit_cast(bf16x8, w);
            }
            bf16x8 Av[4];
            tr_read8(wbase + (unsigned)((32 * ks2 + 4 * quad + (i16 >> 2)) * VPITCH + (4 * (lane & 3)) * 2), Av);
#pragma unroll
            for (int dt = 0; dt < 4; ++dt)
#pragma unroll
                for (int qt = 0; qt < QT; ++qt) O[dt][qt] = __builtin_amdgcn_mfma_f32_16x16x32_bf16(Av[dt], Bp[qt], O[dt][qt], 0, 0, 0);
        }
    }
#pragma unroll
    for (int qt = 0; qt < QT; ++qt) {
        float l = lrun[qt]; l += __shfl_xor(l, 16); l += __shfl_xor(l, 32);
        const float inv = 1.f / l;
#pragma unroll
        for (int dt = 0; dt < 4; ++dt) {
            const f32x4 o = O[dt][qt] * inv;
            u32x2 w; w.x = cvt_pk_bf16(o.x, o.y); w.y = cvt_pk_bf16(o.z, o.w);
            *(u32x2*)(PA + (q0 + qt * 16 + i16) * AC + h * 64 + dt * 16 + quad * 4) = w;
        }
    }
}
__device__ __forceinline__ void attn_sample_unit(LAS unsigned char* wl, const Params& p, int u, int lane) {
    bf16_t* PA = (bf16_t*)(p.ws + WS_PA);
    const int i = u & 15, h = (u >> 4) & 7, sb = u >> 7;
    const size_t qrow = (size_t)MP + sb * 16 + i;
    LAS float* qs = (LAS float*)wl; LAS float* pb = (LAS float*)(wl + 256);
    qs[lane] = bf2f(PA[qrow * AC + h * 64 + lane]);
    const float* ck = p.in[4] + (size_t)(sb * 8 + h) * 512 * 64; const float* cv = p.in[5] + (size_t)(sb * 8 + h) * 512 * 64;
    const float* nk = p.out + O_SK + (size_t)(sb * 8 + h) * 16 * 64; const float* nv = p.out + O_SV + (size_t)(sb * 8 + h) * 16 * 64;
    const float* tabg = p.in[23] + h * 257;
    float mx = -1e30f;
#pragma unroll 1
    for (int ps = 0; ps < 9; ++ps) {
        const int j = ps * 64 + lane;
        if (j < 528) {
            const float* kr = j < 512 ? ck + (size_t)j * 64 : nk + (size_t)(j - 512) * 64;
            float a = 0.f;
#pragma unroll
            for (int d = 0; d < 64; d += 4) { const f32x4 kv = *(const f32x4*)(kr + d); const f32x4 qv = *(const LAS f32x4*)(qs + d); a += kv.x * qv.x + kv.y * qv.y + kv.z * qv.z + kv.w * qv.w; }
            int rel = j - 512 - i; rel = rel < -128 ? -128 : (rel > 128 ? 128 : rel);
            const float s = a * 0.125f + tabg[rel + 128];
            pb[j] = s; mx = fmaxf(mx, s);
        }
    }
    mx = wave_max(mx);
    float sum = 0.f;
#pragma unroll 1
    for (int ps = 0; ps < 9; ++ps) { const int j = ps * 64 + lane; if (j < 528) { const float e = fast_exp(pb[j] - mx); sum += e; pb[j] = e; } }
    sum = wave_sum(sum);
    float o = 0.f;
    float o1 = 0.f, o2 = 0.f, o3 = 0.f;
#pragma unroll 8
    for (int j = 0; j < 512; j += 4) { o += pb[j] * cv[(size_t)j * 64 + lane]; o1 += pb[j + 1] * cv[(size_t)(j + 1) * 64 + lane]; o2 += pb[j + 2] * cv[(size_t)(j + 2) * 64 + lane]; o3 += pb[j + 3] * cv[(size_t)(j + 3) * 64 + lane]; }
#pragma unroll
    for (int j = 0; j < 16; ++j) o += pb[512 + j] * nv[(size_t)j * 64 + lane];
    o += o1 + o2 + o3;
    PA[qrow * AC + h * 64 + lane] = f2bf(o / sum);
}

constexpr int STEP_B = 1344;
template <int NS>
__device__ __forceinline__ void scan_unit(LAS unsigned char* lds, const Params& p, size_t row0, int T, int h, int vq, const float* s_init, float* s_out, int tid) {
    unsigned char* ws = p.ws;
    const float* SW = (const float*)(ws + WS_XB);
    const bf16_t* SR = (const bf16_t*)(ws + WS_S5); const bf16_t* SK = (const bf16_t*)(ws + WS_S5 + S5B); const bf16_t* SV = (const bf16_t*)(ws + WS_S5 + 2 * S5B);
    const bf16_t* SKK = (const bf16_t*)(ws + WS_S5 + 3 * S5B); const bf16_t* SB = (const bf16_t*)(ws + WS_S5 + 4 * S5B);
    float* Y = (float*)(ws + WS_PR);
    constexpr int BUF_B = NS * STEP_B;
    LAS unsigned char* ybase = lds + 2 * 32 * STEP_B;
    const int nchunks = T / NS;
    const bool loader = tid >= 256;
    const int L = tid - 256;
    const int lane = tid & 63, wv = tid >> 6, vi = lane >> 4, kj = lane & 15, rloc = wv * 4 + vi;
    f32x2 S01 = {0.f, 0.f}, S23 = {0.f, 0.f};
    if (!loader && s_init) { const f32x4 s = *(const f32x4*)(s_init + (size_t)(vq * 16 + rloc) * 64 + 4 * kj); S01 = (f32x2){s.x, s.y}; S23 = (f32x2){s.z, s.w}; }
    f32x4 gw_[(NS * 16 + 255) / 256]; u32x4 gkk = {0u, 0u, 0u, 0u}, gb = gkk, gk = gkk, gr = gkk, gv = gkk; float ginv = 0.f;
    const float* INV = (const float*)(ws + WS_INV);
#pragma unroll
    for (int i = 0; i < (NS * 16 + 255) / 256; ++i) gw_[i] = (f32x4){0.f, 0.f, 0.f, 0.f};
    auto issue_chunk = [&](int c) {
        const size_t r0 = row0 + (size_t)c * NS;
#pragma unroll
        for (int i = 0; i < (NS * 16 + 255) / 256; ++i) { const int pz = L + 256 * i; if (pz < NS * 16) { const int st = pz >> 4, o = pz & 15;
            gw_[i] = *(const f32x4*)(SW + (r0 + st) * RW + h * 64 + o * 4); } }
        if (L < NS * 8) { const int st = L >> 3, o = L & 7; const size_t g = (r0 + st) * RW + h * 64 + o * 8;
            gkk = *(const u32x4*)(SKK + g); gb = *(const u32x4*)(SB + g); gk = *(const u32x4*)(SK + g); gr = *(const u32x4*)(SR + g); ginv = INV[(r0 + st) * 8 + h]; }
        if (L < NS * 2) { const int st = L >> 1, hf = L & 1; gv = *(const u32x4*)(SV + (r0 + st) * RW + h * 64 + vq * 16 + hf * 8); }
    };
    auto commit_chunk = [&](int c) {
        LAS unsigned char* buf = lds + (c & 1) * 32 * STEP_B;
#pragma unroll
        for (int i = 0; i < (NS * 16 + 255) / 256; ++i) { const int pz = L + 256 * i; if (pz < NS * 16) { const int st = pz >> 4, o = pz & 15;
            *(LAS f32x4*)(buf + st * STEP_B + o * 16) = gw_[i]; } }
        if (L < NS * 8) { const int st = L >> 3, o = L & 7;
            const u32x4 a = gkk, b = gb, k = gk, r = gr;
            LAS unsigned char* d = buf + st * STEP_B + o * 32;
            *(LAS f32x4*)(d + 256) = (f32x4){bflo(a.x), bfhi(a.x), bflo(a.y), bfhi(a.y)} * ginv; *(LAS f32x4*)(d + 256 + 16) = (f32x4){bflo(a.z), bfhi(a.z), bflo(a.w), bfhi(a.w)} * ginv;
            *(LAS f32x4*)(d + 512) = (f32x4){bflo(b.x), bfhi(b.x), bflo(b.y), bfhi(b.y)} * ginv; *(LAS f32x4*)(d + 512 + 16) = (f32x4){bflo(b.z), bfhi(b.z), bflo(b.w), bfhi(b.w)} * ginv;
            *(LAS f32x4*)(d + 768) = (f32x4){bflo(k.x), bfhi(k.x), bflo(k.y), bfhi(k.y)}; *(LAS f32x4*)(d + 768 + 16) = (f32x4){bflo(k.z), bfhi(k.z), bflo(k.w), bfhi(k.w)};
            *(LAS f32x4*)(d + 1024) = (f32x4){bflo(r.x), bfhi(r.x), bflo(r.y), bfhi(r.y)}; *(LAS f32x4*)(d + 1024 + 16) = (f32x4){bflo(r.z), bfhi(r.z), bflo(r.w), bfhi(r.w)}; }
        if (L < NS * 2) { const int st = L >> 1, hf = L & 1; const u32x4 v = gv;
            LAS unsigned char* d = buf + st * STEP_B + 1280 + hf * 32;
            *(LAS f32x4*)d = (f32x4){bflo(v.x), bfhi(v.x), bflo(v.y), bfhi(v.y)}; *(LAS f32x4*)(d + 16) = (f32x4){bflo(v.z), bfhi(v.z), bflo(v.w), bfhi(v.w)}; }
    };
    auto flush_y = [&](int c) {
        if (L < NS * 4) { const int st = L >> 2, q = L & 3; const f32x4 v = *(const LAS f32x4*)(ybase + (c & 1) * 2048 + st * 64 + q * 16);
            *(f32x4*)(Y + (row0 + (size_t)c * NS + st) * RW + h * 64 + vq * 16 + q * 4) = v; }
    };
#define SCAN_BAR() do { asm volatile("s_waitcnt lgkmcnt(0)" ::: "memory"); __builtin_amdgcn_s_barrier(); asm volatile("" ::: "memory"); } while (0)
    if (loader) { issue_chunk(0); commit_chunk(0); if (nchunks > 1) issue_chunk(1); }
    SCAN_BAR();
    for (int c = 0; c < nchunks; ++c) {
        if (loader) {
            if (c + 1 < nchunks) commit_chunk(c + 1);
            if (c + 2 < nchunks) issue_chunk(c + 2);
            if (c > 0) flush_y(c - 1);
        } else {
            LAS unsigned char* buf = lds + (c & 1) * 32 * STEP_B;
            LAS float* yb = (LAS float*)(ybase + (c & 1) * 2048);
            f32x4 w4 = *(const LAS f32x4*)(buf + kj * 16), kk4 = *(const LAS f32x4*)(buf + 256 + kj * 16), b4 = *(const LAS f32x4*)(buf + 512 + kj * 16),
                  k4 = *(const LAS f32x4*)(buf + 768 + kj * 16), r4 = *(const LAS f32x4*)(buf + 1024 + kj * 16);
            float vv = *(const LAS float*)(buf + 1280 + rloc * 4);
            float ykeep = 0.f, ypart = 0.f;
#pragma unroll
            for (int s = 0; s <= NS; ++s) {
                f32x4 w4n = w4, kk4n = kk4, b4n = b4, k4n = k4, r4n = r4; float vvn = vv;
                if (s + 1 < NS) { LAS unsigned char* sp = buf + (s + 1) * STEP_B;
                    w4n = *(const LAS f32x4*)(sp + kj * 16); kk4n = *(const LAS f32x4*)(sp + 256 + kj * 16); b4n = *(const LAS f32x4*)(sp + 512 + kj * 16);
                    k4n = *(const LAS f32x4*)(sp + 768 + kj * 16); r4n = *(const LAS f32x4*)(sp + 1024 + kj * 16); vvn = *(const LAS float*)(sp + 1280 + rloc * 4); }
                float sa = 0.f;
                if (s < NS) { f32x2 t = S01 * (f32x2){kk4.x, kk4.y}; t = S23 * (f32x2){kk4.z, kk4.w} + t; sa = t.x + t.y; }
                float yr = ypart;
                sa += dppf<0xB1>(sa); yr += dppf<0xB1>(yr);
                sa += dppf<0x4E>(sa); yr += dppf<0x4E>(yr);
                sa += dppf<0x141>(sa); yr += dppf<0x141>(yr);
                sa += dppf<0x140>(sa); yr += dppf<0x140>(yr);
                if (s > 0) { ykeep = (kj == ((s - 1) & 15)) ? yr : ykeep;
                    if (((s - 1) & 15) == 15) yb[((s - 1) - 15 + kj) * 16 + rloc] = ykeep; }
                if (s < NS) {
                    const f32x2 vk01 = (f32x2){vv, vv} * (f32x2){k4.x, k4.y}, vk23 = (f32x2){vv, vv} * (f32x2){k4.z, k4.w};
                    S01 = S01 * (f32x2){w4.x, w4.y} + vk01; S23 = S23 * (f32x2){w4.z, w4.w} + vk23;
                    const f32x2 nsa = {-sa, -sa};
                    S01 = nsa * (f32x2){b4.x, b4.y} + S01; S23 = nsa * (f32x2){b4.z, b4.w} + S23;
                    f32x2 yy = S01 * (f32x2){r4.x, r4.y}; yy = S23 * (f32x2){r4.z, r4.w} + yy;
                    ypart = yy.x + yy.y;
                }
                w4 = w4n; kk4 = kk4n; b4 = b4n; k4 = k4n; r4 = r4n; vv = vvn;
            }
        }
        SCAN_BAR();
    }
    if (loader) flush_y(nchunks - 1);
    else *(f32x4*)(s_out + (size_t)(vq * 16 + rloc) * 64 + 4 * kj) = (f32x4){S01.x, S01.y, S23.x, S23.y};
    SCAN_BAR();
#undef SCAN_BAR
}

__device__ __forceinline__ void post_row(const Params& p, int row, int lane) {
    unsigned char* ws = p.ws;
    const float* Y = (const float*)(ws + WS_PR); const bf16_t* PA = (const bf16_t*)(ws + WS_PA); const bf16_t* SV = (const bf16_t*)(ws + WS_S5 + 2 * S5B);
    const bf16_t* SG = (const bf16_t*)(ws + WS_G); const float* BON = (const float*)(ws + WS_BON); bf16_t* MIX = (bf16_t*)(ws + WS_S5);
    const int c0 = lane * 8, h = lane >> 3;
    const f32x4 y0 = *(const f32x4*)(Y + (size_t)row * RW + c0), y1 = *(const f32x4*)(Y + (size_t)row * RW + c0 + 4);
    float yv[8] = {y0.x, y0.y, y0.z, y0.w, y1.x, y1.y, y1.z, y1.w};
    float s = 0.f;
#pragma unroll
    for (int j = 0; j < 8; ++j) s += yv[j];
    const float mean = row8_sum(s) * (1.f / 64.f);
    float s2 = 0.f;
#pragma unroll
    for (int j = 0; j < 8; ++j) { yv[j] -= mean; s2 += yv[j] * yv[j]; }
    const float rstd = rsqrtf(row8_sum(s2) * (1.f / 64.f) + GN_EPS);
    const u32x4 vu = *(const u32x4*)(SV + (size_t)row * RW + c0), gu = *(const u32x4*)(SG + (size_t)row * RW + c0);
    const float vf[8] = {bflo(vu.x), bfhi(vu.x), bflo(vu.y), bfhi(vu.y), bflo(vu.z), bfhi(vu.z), bflo(vu.w), bfhi(vu.w)};
    const float gf[8] = {bflo(gu.x), bfhi(gu.x), bflo(gu.y), bfhi(gu.y), bflo(gu.z), bfhi(gu.z), bflo(gu.w), bfhi(gu.w)};
    const float bd = BON[(size_t)row * 8 + h];
    const float* lw = p.in[21] + c0; const float* lb = p.in[22] + c0;
    float o[8];
#pragma unroll
    for (int j = 0; j < 8; ++j) o[j] = (yv[j] * rstd * lw[j] + lb[j] + bd * vf[j]) * gf[j];
    u32x4 w; w.x = cvt_pk_bf16(o[0], o[1]); w.y = cvt_pk_bf16(o[2], o[3]); w.z = cvt_pk_bf16(o[4], o[5]); w.w = cvt_pk_bf16(o[6], o[7]);
    *(u32x4*)(MIX + (size_t)row * D + c0) = w;
    *(u32x4*)(MIX + (size_t)row * D + 512 + c0) = *(const u32x4*)(PA + (size_t)row * AC + c0);
}


__device__ __forceinline__ void rowss_phase(const float* XR, float* ss, int gw, int NGW, int lane) {
    for (int m = gw; m < M; m += NGW) {
        const f32x4* xr = (const f32x4*)(XR + (size_t)m * D) + lane; float s = 0.f;
#pragma unroll
        for (int j = 0; j < 4; ++j) { const f32x4 v = xr[64 * j]; s += v.x * v.x + v.y * v.y + v.z * v.z + v.w * v.w; }
        s = wave_sum(s);
        if (lane == 0) ss[m] = s;
    }
}

__device__ __forceinline__ void fix_sample_rows(float* XR, const float* slab, int nsl, float scale, float* ssn, bf16_t* XBo, int gw, int NGW, int lane) {
    for (int m = MP + gw; m < M; m += NGW) {
        f32x4* xr = (f32x4*)(XR + (size_t)m * D) + lane; f32x4 v[4], a[4]; float s = 0.f;
#pragma unroll
        for (int j = 0; j < 4; ++j) { v[j] = xr[64 * j]; a[j] = (f32x4){0.f, 0.f, 0.f, 0.f}; }
        for (int q = 0; q < nsl; ++q) { const f32x4* sp = (const f32x4*)(slab + (size_t)q * (MS * D) + (size_t)(m - MP) * D) + lane;
#pragma unroll
            for (int j = 0; j < 4; ++j) a[j] += sp[64 * j]; }
#pragma unroll
        for (int j = 0; j < 4; ++j) { v[j] += scale * a[j]; xr[64 * j] = v[j]; s += v[j].x * v[j].x + v[j].y * v[j].y + v[j].z * v[j].z + v[j].w * v[j].w; }
        s = wave_sum(s);
        if (ssn && lane == 0) ssn[m] = s;
        if (XBo) { u32x2* o8 = (u32x2*)(XBo + (size_t)m * D) + lane;
#pragma unroll
            for (int j = 0; j < 4; ++j) { u32x2 o; o.x = cvt_pk_bf16(v[j].x, v[j].y); o.y = cvt_pk_bf16(v[j].z, v[j].w); o8[64 * j] = o; } }
    }
}

#define XB_TMO      128
#define XB_XCNT(j)  (256  + 64 * (j))
#define XB_XSUB(j)  (1280 + 64 * (j))
#define XB_XGEN(j)  (2304 + 64 * (j))
#define XB_TOP      3328
#define XB_TOPGEN   3392
#define XCD_BAR_WORDS 3456
#define XB_SPIN_CAP (1u << 22)
__device__ __forceinline__ unsigned xb_ld(unsigned* p)              { return __hip_atomic_load(p, __ATOMIC_RELAXED, __HIP_MEMORY_SCOPE_AGENT); }
__device__ __forceinline__ unsigned xb_add(unsigned* p, unsigned v) { return __hip_atomic_fetch_add(p, v, __ATOMIC_RELAXED, __HIP_MEMORY_SCOPE_AGENT); }
__device__ __forceinline__ unsigned xb_xcc_id() { return (unsigned)__builtin_amdgcn_s_getreg((3 << 11) | 20) & 0xFu; }
#define XB_SPIN(cond, bar) do { unsigned _sp = 0; while (cond) { __builtin_amdgcn_s_sleep(1); \
    if ((++_sp & 255u) == 0u) { if (xb_ld(&(bar)[XB_TMO])) break; if (_sp > XB_SPIN_CAP) { atomicAdd(&(bar)[XB_TMO], 1u); break; } } } } while (0)
struct XcdBarrier { unsigned* bar; unsigned x; volatile LAS unsigned* st; };
__device__ __forceinline__ XcdBarrier xcd_barrier_post(unsigned* bar, volatile LAS unsigned* st) {
    XcdBarrier b; b.bar = bar; b.x = xb_xcc_id(); b.st = st;
    if (threadIdx.x == 0) (void)xb_add(&bar[XB_XCNT(b.x)], 1u);
    return b;
}
__device__ __forceinline__ void xcd_barrier_complete(unsigned* bar, unsigned x, unsigned& nloc, unsigned& nx) {
    const unsigned G = gridDim.x * gridDim.y * gridDim.z;
    unsigned sum, cnt, mine, sp = 0u;
    for (;;) {
        sum = 0u; cnt = 0u; mine = 0u;
#pragma unroll
        for (unsigned j = 0; j < 16; ++j) { const unsigned c = xb_ld(&bar[XB_XCNT(j)]); sum += c; cnt += (c > 0u) ? 1u : 0u; mine = (j == x) ? c : mine; }
        if (sum == G) break;
        __builtin_amdgcn_s_sleep(1);
        if ((++sp & 255u) == 0u) { if (xb_ld(&bar[XB_TMO])) break; if (sp > XB_SPIN_CAP) { atomicAdd(&bar[XB_TMO], 1u); break; } }
    }
    nloc = mine > 0u ? mine : 1u; nx = cnt > 0u ? cnt : 1u;
}
__device__ __forceinline__ void xcd_barrier(const XcdBarrier& b) {
    asm volatile("s_waitcnt vmcnt(0)" ::: "memory");
    __syncthreads();
    if (threadIdx.x == 0) {
        unsigned* bar = b.bar;
        __builtin_amdgcn_s_waitcnt(0);
        unsigned nloc = b.st[0], nx = b.st[1];
        if (nloc == 0u) { xcd_barrier_complete(bar, b.x, nloc, nx); b.st[0] = nloc; b.st[1] = nx; }
        const unsigned old = xb_add(&bar[XB_XSUB(b.x)], 1u);
        const unsigned gen = old / nloc;
        if (old + 1u == (gen + 1u) * nloc) {
            __builtin_amdgcn_fence(__ATOMIC_RELEASE, "agent");
            asm volatile("s_waitcnt vmcnt(0)" ::: "memory");
            const unsigned og = xb_add(&bar[XB_TOP], 1u);
            const unsigned tg = og / nx;
            if (og + 1u == (tg + 1u) * nx) xb_add(&bar[XB_TOPGEN], 1u);
            else XB_SPIN(xb_ld(&bar[XB_TOPGEN]) == tg, bar);
            __builtin_amdgcn_fence(__ATOMIC_ACQUIRE, "agent");
            xb_add(&bar[XB_XGEN(b.x)], 1u);
            asm volatile("s_waitcnt vmcnt(0)" ::: "memory");
        } else {
            XB_SPIN(xb_ld(&bar[XB_XGEN(b.x)]) == gen, bar);
            __builtin_amdgcn_fence(__ATOMIC_ACQUIRE, "agent");
            asm volatile("s_waitcnt vmcnt(0)" ::: "memory");
        }
    }
    __syncthreads();
}

__global__ void __launch_bounds__(512, 2) fwd_kernel(Params p) {
    extern __shared__ __attribute__((aligned(16))) unsigned char lds_raw[];
    LAS unsigned char* lds = (LAS unsigned char*)lds_raw;
    cg::grid_group grid = cg::this_grid();
    const int tid = threadIdx.x, lane = tid & 63, wave = __builtin_amdgcn_readfirstlane(tid >> 6);
    const int G = gridDim.x, bx = blockIdx.x;
    const int vcu = (G % 8 == 0) ? (bx % 8) * (G / 8) + bx / 8 : bx;
    const int gw = vcu * 8 + wave, NGW = G * 8;
    unsigned char* ws = p.ws;
    const int lo = p.ph_lo, hi = p.ph_hi;
    volatile LAS unsigned* xbst = (volatile LAS unsigned*)(lds + 131072);
    if (tid < 2) xbst[tid] = 0u;
    __syncthreads();
    XcdBarrier xbar = xcd_barrier_post((unsigned*)ws, xbst);
#ifndef PHMASK
#define PHMASK 0xFFFF
#endif
#define IN(k) (((PHMASK >> (k)) & 1) && lo <= (k) && (k) < hi)
#ifndef REP_PHASE
#define REP_PHASE -1
#endif
#define REPS(k) for (int rep_ = 0; rep_ < ((k) == REP_PHASE ? 2 : 1); ++rep_)
#define SEAM(k) do { if (IN(k) && IN((k) + 1)) { if (lo < 0) { asm volatile("s_waitcnt vmcnt(0) lgkmcnt(0)" ::: "memory"); __syncthreads(); grid.sync(); } else xcd_barrier(xbar); } } while (0)
    float* XR = p.out;
    bf16_t* XB = (bf16_t*)(ws + WS_XB); bf16_t* ACT = (bf16_t*)(ws + WS_PR); bf16_t* X2B = XB; bf16_t* MIXB = (bf16_t*)(ws + WS_S5);
    float* SLAB = (float*)(ws + WS_SLAB);
    float* ss1 = (float*)(ws + WS_SS1); float* ss2 = (float*)(ws + WS_SS2); float* ss3 = (float*)(ws + WS_SS3); float* ss4 = (float*)(ws + WS_SS4);

    if (IN(0)) REPS(0) phase0(p, lds, gw, NGW, wave, lane);
    SEAM(0);
    if (IN(1)) REPS(1) { pg8::Gemm g{XB, (const bf16_t*)(ws + WS_WGU1), M, 2 * FF, D}; pg8::StaticOrder S; S.init(M, 2 * FF, D, G, bx, 0);
        EpiGU E{ACT, ss1}; pg8::gemm_phase<EpiGU>(lds, g, S, E); }
    SEAM(1);
    if (IN(2)) { pg8::Gemm g{ACT, (const bf16_t*)(ws + WS_WD1), M, D, FF}; pg8::StaticOrder S; S.init(MP, D, FF, G, bx, 11);
        EpiRes E{p.in[0], p.in[1], XR, XB, ss2, 0.5f, SLAB, 4}; pg8::gemm_phase<EpiRes, true>(lds, g, S, E);
        xcd_barrier(xbar); fix_sample_rows(XR, SLAB, 11, 0.5f, ss2, XB, gw, NGW, lane); }
    SEAM(2);
    if (IN(3)) { pg8::Gemm g{XB, (const bf16_t*)(ws + WS_WIN), M, NIN, D}; pg8::StaticOrder S; S.init(M, NIN, D, G, bx, 0);
        EpiIn E{(bf16_t*)(ws + WS_PR), (bf16_t*)(ws + WS_PA), ss2, p.out}; pg8::gemm_phase<EpiIn>(lds, g, S, E); }
    SEAM(3);
    if (IN(4)) {
        prep_load_params(lds, p, tid);
        REPS(4) { for (int ug = vcu; ug < MP / 128; ug += G) prep_unit(lds, p, ug * 8 + wave, lane, tid, 0, 8);
            for (int st = vcu; st < 16; st += G) prep_unit(lds, p, (MP / 128 + (st >> 3)) * 8 + wave, lane, tid, st & 7, (st & 7) + 1); }
        __syncthreads();
        LAS unsigned char* wl = lds + wave * ATT_WL;
        for (int u = gw; u < 8 * 128 * 8 * 2; u += NGW) attn_prompt_unit(wl, (bf16_t*)(ws + WS_PA), p.in[23], u, lane);
        for (int u = gw; u < 16 * 8 * 16; u += NGW) attn_sample_unit(wl, p, u, lane);
    }
    SEAM(4);
    if (IN(5)) REPS(5) {
        for (int u = vcu; u < 256; u += G) { const int bh = u >> 2, vq = u & 3, b = bh >> 3, h = bh & 7;
            scan_unit<32>(lds, p, (size_t)b * SEQ, SEQ, h, vq, nullptr, p.out + O_PWKV + (size_t)bh * 4096, tid); }
        for (int u = vcu; u < 512; u += G) { const int bh = u >> 2, vq = u & 3, sb = bh >> 3, h = bh & 7;
            scan_unit<16>(lds, p, (size_t)MP + sb * 16, 16, h, vq, p.in[3] + (size_t)bh * 4096, p.out + O_SWKV + (size_t)bh * 4096, tid); }
    }
    SEAM(5);
    if (IN(6)) REPS(6) { for (int m = gw; m < M; m += NGW) post_row(p, m, lane); }
    SEAM(6);
    if (IN(7)) { pg8::Gemm g{MIXB, (const bf16_t*)(ws + WS_WOUT), M, D, D}; pg8::StaticOrder S; S.init(MP, D, D, G, bx, 4);
        EpiRes E{XR, XR + (size_t)MP * D, XR, X2B, ss3, 1.0f, SLAB, 4}; pg8::gemm_phase<EpiRes, true>(lds, g, S, E);
        xcd_barrier(xbar); fix_sample_rows(XR, SLAB, 4, 1.0f, ss3, X2B, gw, NGW, lane); }
    SEAM(7);
    if (IN(8)) { pg8::Gemm g{X2B, (const bf16_t*)(ws + WS_WGU2), M, 2 * FF, D}; pg8::StaticOrder S; S.init(M, 2 * FF, D, G, bx, 0);
        EpiGU E{ACT, ss3}; pg8::gemm_phase<EpiGU>(lds, g, S, E); }
    SEAM(8);
    if (IN(9)) { pg8::Gemm g{ACT, (const bf16_t*)(ws + WS_WD2), M, D, FF}; pg8::StaticOrder S; S.init(MP, D, FF, G, bx, 11);
        EpiRes E{XR, XR + (size_t)MP * D, XR, nullptr, nullptr, 0.5f, SLAB, 4}; pg8::gemm_phase<EpiRes, true>(lds, g, S, E);
        xcd_barrier(xbar); fix_sample_rows(XR, SLAB, 11, 0.5f, nullptr, nullptr, gw, NGW, lane); }
    SEAM(9);
    if (IN(10)) {
        const float* nf = p.in[29];
        for (int m = gw; m < M; m += NGW) {
            f32x4* xr = (f32x4*)(XR + (size_t)m * D) + lane;
            f32x4 v[4]; float sq = 0.f;
#pragma unroll
            for (int j = 0; j < 4; ++j) { v[j] = xr[64 * j]; sq += v[j].x * v[j].x + v[j].y * v[j].y + v[j].z * v[j].z + v[j].w * v[j].w; }
            const float rs = rsqrtf(wave_sum(sq) * (1.f / 1024.f) + NORM_EPS);
#pragma unroll
            for (int j = 0; j < 4; ++j) { const f32x4 g4 = *((const f32x4*)nf + 64 * j + lane); xr[64 * j] = v[j] * rs * g4; }
        }
    }
#ifdef DUMP
    if (lo == 13) {
        const bf16_t* MIXd = (const bf16_t*)(ws + WS_S5);
        const float* Yd = (const float*)(ws + WS_PR); const bf16_t* SGd = (const bf16_t*)(ws + WS_G); const bf16_t* SRd = (const bf16_t*)(ws + WS_S5);
        const bf16_t* PAd = (const bf16_t*)(ws + WS_PA);
        for (int m = gw; m < M; m += NGW)
            for (int c = lane; c < D; c += 64) { float v = 0.f;
                if (DUMP == 2 && c < 512) v = bf2f(MIXd[(size_t)m * D + c]);
                if (DUMP == 3 && c >= 512) v = bf2f(MIXd[(size_t)m * D + c]);
                if (DUMP == 4 && c < 512) v = Yd[(size_t)m * RW + c];
                if (DUMP == 5 && c < 512) v = bf2f(SGd[(size_t)m * RW + c]);
                if (DUMP == 6 && c < 512) v = bf2f(SRd[(size_t)m * RW + c]);
                if (DUMP == 7 && c < 512) v = bf2f(PAd[(size_t)m * AC + c]);
                if (DUMP == 8 && c < 128) v = bf2f(((const bf16_t*)(ws + WS_PR))[(size_t)m * RC + 1664 + c]);
                if (DUMP == 9 && c < 128) v = bf2f(((const bf16_t*)(ws + WS_GL))[(size_t)(m & 511) * 128 + c]);
                XR[(size_t)m * D + c] = v; }
    }
#endif
#undef IN
#undef SEAM
}

extern "C" void kernel_launch(void* const* d_in, const int* in_sizes, int n_in, void* d_out, int out_size, void* d_ws, size_t ws_size, hipStream_t stream) {
    static int grid = 0;
    if (grid == 0) {
        if (n_in != 30 || ws_size < WS_END) { fprintf(stderr, "kernel_launch: unexpected n_in %d or ws_size %zu (< %zu)\n", n_in, ws_size, (size_t)WS_END); grid = -1; return; }
        int dev = 0, cus = 0, per_cu = 0;
        (void)hipGetDevice(&dev); (void)hipDeviceGetAttribute(&cus, hipDeviceAttributeMultiprocessorCount, dev);
        if (hipFuncSetAttribute((const void*)fwd_kernel, hipFuncAttributeMaxDynamicSharedMemorySize, LDS_BYTES) != hipSuccess) { fprintf(stderr, "kernel_launch: hipFuncSetAttribute failed\n"); grid = -1; return; }
        if (hipOccupancyMaxActiveBlocksPerMultiprocessor(&per_cu, (const void*)fwd_kernel, 512, LDS_BYTES) != hipSuccess || per_cu < 1) { fprintf(stderr, "kernel_launch: occupancy query failed (%d)\n", per_cu); (void)hipGetLastError(); per_cu = 1; }
        grid = cus * per_cu;
    }
    if (grid < 0) return;
    Params p{};
    for (int i = 0; i < 30; ++i) p.in[i] = (const float*)d_in[i];
    p.out = (float*)d_out; p.ws = (unsigned char*)d_ws;
    (void)hipMemsetAsync(d_ws, 0, XCD_BAR_WORDS * 4, stream);
#ifndef MULTI_LAUNCH
#define MULTI_LAUNCH 0
#endif
#ifndef NPH
#define NPH 11

#endif
#if MULTI_LAUNCH
    for (int k = 0; k < NPH; ++k) { p.ph_lo = k; p.ph_hi = k + 1; hipLaunchKernelGGL(fwd_kernel, dim3(grid), dim3(512), LDS_BYTES, stream, p); }
#ifdef DUMP
    p.ph_lo = 13; p.ph_hi = 14; hipLaunchKernelGGL(fwd_kernel, dim3(grid), dim3(512), LDS_BYTES, stream, p);
#endif
#else
    p.ph_lo = 0; p.ph_hi = 11;
    void* args[] = {&p};
    hipError_t e = hipLaunchCooperativeKernel((const void*)fwd_kernel, dim3(grid), dim3(512), args, LDS_BYTES, stream);
    if (e != hipSuccess) fprintf(stderr, "kernel_launch: cooperative launch failed: %s (grid %d)\n", hipGetErrorString(e), grid);
#endif
}
```
